# Optimizing an MI355X kernel written in HIP

```python
import jax, jax.numpy as jnp
from jax import lax
import numpy as np

D_MODEL = 2048
BATCH = 2
SEQ = 4096
DEPTH = 4
DEC_BATCH = 8
DEC_SEQ = 4096
PAST_LEN = 128

GRID_W = 64
N_MEM = 256
MIX_W = 2 * D_MODEL
MEM_HEADS = 4
MEM_HD = 256
MEM_W = MEM_HEADS * MEM_HD
TOK_W = MIX_W - MEM_W
HG_DK = 128
HG_DV = 128
HG_HEADS = TOK_W // HG_DV
NA_HD = 128
NA_HEADS = TOK_W // NA_HD
NA_KH = 8
NA_KW = 16
CHUNK = 32
N_A_LAYERS = (DEPTH + 1) // 2
N_B_LAYERS = DEPTH // 2
P_A = 4 * TOK_W + MEM_W + MIX_W
P_B = 3 * TOK_W + MEM_W + MIX_W
EPS = 1e-6

kernel_name = "hybrid_hgrn2_natten_memory_encoder"


def rms_norm(x, g):
    xf = x.astype(jnp.float32)
    y = xf * lax.rsqrt(jnp.mean(xf * xf, axis=-1, keepdims=True) + EPS)
    return (y * g.astype(jnp.float32)).astype(x.dtype)


def _to_chunks(a):
    n, b, t, h, d = a.shape
    return a.reshape(n, b, t // CHUNK, CHUNK, h, d).transpose(2, 0, 1, 4, 3, 5)


def gla_chunk_scan(q, k, v, log_f):
    n, b, t, h, dk = q.shape
    dv = v.shape[-1]
    tri = jnp.tril(jnp.ones((CHUNK, CHUNK), dtype=bool))

    def step(S, inp):
        qc, kc, vc, gc = inp
        cb = jnp.cumsum(gc, axis=-2)
        cb_last = cb[..., -1, :]
        diff = cb[..., :, None, :] - cb[..., None, :, :]
        decay = jnp.exp(jnp.where(tri[:, :, None], diff, -jnp.inf))
        A = jnp.einsum('...td,...sd,...tsd->...ts', qc, kc, decay)
        o = jnp.einsum('...ts,...sv->...tv', A, vc) + jnp.einsum('...td,...dv->...tv', qc * jnp.exp(cb), S)
        S_new = S * jnp.exp(cb_last)[..., :, None] + jnp.einsum(
            '...sd,...sv->...dv', kc * jnp.exp(cb_last[..., None, :] - cb), vc)
        return S_new, o

    S0 = jnp.zeros((n, b, h, dk, dv), jnp.float32)
    _, o = lax.scan(step, S0, (_to_chunks(q), _to_chunks(k), _to_chunks(v), _to_chunks(log_f)))
    return o.transpose(1, 2, 0, 4, 3, 5).reshape(n, b, t, h, dv)


def hgrn2_bidir(q, f_fwd, f_bwd, iv, lb, onorm_g):
    B, T, _ = q.shape
    f32 = jnp.float32
    shp = (B, T, HG_HEADS, HG_DK)
    f_pre = jnp.stack([f_fwd.reshape(shp), f_bwd.reshape(shp)]).astype(f32)
    lbr = lb.reshape(2, 1, 1, HG_HEADS, HG_DK)
    log_f = jnp.logaddexp(jnp.log(lbr), jnp.log1p(-lbr) + jax.nn.log_sigmoid(f_pre))
    k = (1.0 - lbr) * jax.nn.sigmoid(-f_pre)
    qs = jax.nn.silu(q.reshape(shp).astype(f32)) * (HG_DK ** -0.5)
    vv = iv.reshape(B, T, HG_HEADS, HG_DV).astype(f32)
    qd = jnp.stack([qs, qs[:, ::-1]])
    vd = jnp.stack([vv, vv[:, ::-1]])
    kd = jnp.stack([k[0], k[1][:, ::-1]])
    gd = jnp.stack([log_f[0], log_f[1][:, ::-1]])
    o = gla_chunk_scan(qd, kd, vd, gd)
    o = o[0] + o[1][:, ::-1]
    o = o * lax.rsqrt(jnp.mean(o * o, axis=-1, keepdims=True) + EPS)
    return o.reshape(B, T, TOK_W) * onorm_g.astype(f32)


def neighborhood_attention(q, k, v, rpb):
    B, T, _ = q.shape
    rows = T // GRID_W
    kh = min(NA_KH, rows)
    kw = NA_KW
    qg = q.reshape(B, rows, GRID_W, NA_HEADS, NA_HD) * (NA_HD ** -0.5)
    kg = k.reshape(B, rows, GRID_W, NA_HEADS, NA_HD)
    vg = v.reshape(B, rows, GRID_W, NA_HEADS, NA_HD)
    col = jnp.arange(GRID_W)
    cs = jnp.clip(col - kw // 2, 0, GRID_W - kw)
    col_mask = (col[None, :] >= cs[:, None]) & (col[None, :] < cs[:, None] + kw)
    dc_idx = jnp.clip(col[None, :] - col[:, None] + (kw - 1), 0, 2 * kw - 2)
    rpb_c = rpb.astype(jnp.float32)[:, :, dc_idx]

    def row_block(r):
        rs = jnp.clip(r - kh // 2, 0, rows - kh)
        kb = lax.dynamic_slice_in_dim(kg, rs, kh, axis=1)
        vb = lax.dynamic_slice_in_dim(vg, rs, kh, axis=1)
        qr = lax.dynamic_index_in_dim(qg, r, axis=1, keepdims=False)
        dr_idx = rs + jnp.arange(kh) - r + (NA_KH - 1)
        bias = jnp.take(rpb_c, dr_idx, axis=1).transpose(0, 2, 1, 3)
        s = jnp.einsum('bqhd,bjkhd->bhqjk', qr, kb).astype(jnp.float32) + bias[None]
        s = jnp.where(col_mask[:, None, :], s, -jnp.inf)
        p = jax.nn.softmax(s.reshape(B, NA_HEADS, GRID_W, kh * GRID_W), axis=-1)
        p = p.reshape(B, NA_HEADS, GRID_W, kh, GRID_W).astype(v.dtype)
        return jnp.einsum('bhqjk,bjkhd->bqhd', p, vb)

    out = lax.map(row_block, jnp.arange(rows))
    return out.transpose(1, 0, 2, 3, 4).reshape(B, T, TOK_W)


def memory_attention(qm, km, vm):
    B, T, _ = qm.shape
    qh = qm.reshape(B, T, MEM_HEADS, MEM_HD)
    kh = km.reshape(B, -1, MEM_HEADS, MEM_HD)
    vh = vm.reshape(B, -1, MEM_HEADS, MEM_HD)
    s = jnp.einsum('bthd,bmhd->bhtm', qh, kh).astype(jnp.float32) * (MEM_HD ** -0.5)
    p = jax.nn.softmax(s, axis=-1).astype(vm.dtype)
    return jnp.einsum('bhtm,bmhd->bthd', p, vh).reshape(B, T, MEM_W)


def trunk(x, mem, w_in_a, w_in_b, w_mem_kv, w_out, norm_g, mem_norm_g, lower_bounds, hg_onorm_g, na_rpb, final_g):
    split_a = [int(c) for c in np.cumsum([TOK_W] * 4 + [MEM_W])]
    split_b = [int(c) for c in np.cumsum([TOK_W] * 3 + [MEM_W])]
    for i in range(DEPTH):
        h = rms_norm(x, norm_g[i])
        km, vm = jnp.split(rms_norm(mem, mem_norm_g[i]) @ w_mem_kv[i], 2, axis=-1)
        if i % 2 == 0:
            a = i // 2
            q, f_f, f_b, iv, qm, gate = jnp.split(h @ w_in_a[a], split_a, axis=-1)
            o_mix = hgrn2_bidir(q, f_f, f_b, iv, lower_bounds[a], hg_onorm_g[a]).astype(x.dtype)
        else:
            bi = i // 2
            q, k, v, qm, gate = jnp.split(h @ w_in_b[bi], split_b, axis=-1)
            o_mix = neighborhood_attention(q, k, v, na_rpb[bi])
        o_mem = memory_attention(qm, km, vm)
        o = jnp.concatenate([o_mix, o_mem], axis=-1) * jax.nn.silu(gate)
        x = x + o @ w_out[i]
    return rms_norm(x, final_g)


def setup_inputs(seed: int = 0) -> dict:
    key = jax.random.key(seed)
    ks = jax.random.split(key, 16)
    f32 = jnp.float32
    nrm = jax.random.normal
    return {
        "x_prompt": nrm(ks[0], (BATCH, SEQ, D_MODEL), f32),
        "x_sample": nrm(ks[1], (DEC_BATCH, DEC_SEQ, D_MODEL), f32),
        "mem_prompt": nrm(ks[2], (BATCH, N_MEM, D_MODEL), f32),
        "mem_sample": nrm(ks[3], (DEC_BATCH, N_MEM, D_MODEL), f32),
        "w_in_a": nrm(ks[4], (N_A_LAYERS, D_MODEL, P_A), f32) * (D_MODEL ** -0.5),
        "w_in_b": nrm(ks[5], (N_B_LAYERS, D_MODEL, P_B), f32) * (D_MODEL ** -0.5),
        "w_mem_kv": nrm(ks[6], (DEPTH, D_MODEL, 2 * MEM_W), f32) * (D_MODEL ** -0.5),
        "w_out": nrm(ks[7], (DEPTH, MIX_W, D_MODEL), f32) * (MIX_W ** -0.5),
        "norm_g": 1.0 + 0.02 * nrm(ks[8], (DEPTH, D_MODEL), f32),
        "mem_norm_g": 1.0 + 0.02 * nrm(ks[9], (DEPTH, D_MODEL), f32),
        "hg_lb_logits": 0.5 * nrm(ks[10], (N_A_LAYERS, 2, TOK_W), f32),
        "hg_onorm_g": 1.0 + 0.02 * nrm(ks[11], (N_A_LAYERS, TOK_W), f32),
        "na_rpb": 0.1 * nrm(ks[12], (N_B_LAYERS, NA_HEADS, 2 * NA_KH - 1, 2 * NA_KW - 1), f32),
        "final_g": 1.0 + 0.02 * nrm(ks[13], (D_MODEL,), f32),
    }


def reference(x_prompt, x_sample, mem_prompt, mem_sample, w_in_a, w_in_b, w_mem_kv, w_out,
              norm_g, mem_norm_g, hg_lb_logits, hg_onorm_g, na_rpb, final_g):
    p = jax.nn.softmax(hg_lb_logits.astype(jnp.float32), axis=0)
    lower_bounds = jnp.cumsum(p, axis=0) - p[0:1]
    y_prompt = trunk(x_prompt, mem_prompt, w_in_a, w_in_b, w_mem_kv, w_out, norm_g, mem_norm_g,
                     lower_bounds, hg_onorm_g, na_rpb, final_g)
    y_sample = trunk(x_sample, mem_sample, w_in_a, w_in_b, w_mem_kv, w_out, norm_g, mem_norm_g,
                     lower_bounds, hg_onorm_g, na_rpb, final_g)
    return (y_prompt, y_sample)
```

```cpp
#include <hip/hip_runtime.h>
#include <cstdio>
#include <cstdint>
namespace pg8 {
#define PG8_LAS __attribute__((address_space(3)))
typedef unsigned short bf16_t;
typedef short bf16x8 __attribute__((ext_vector_type(8)));
typedef float f32x4 __attribute__((ext_vector_type(4)));
typedef unsigned u32x4 __attribute__((ext_vector_type(4)));
constexpr int BM = 256, BK = 64, HALF = 128, HTB = HALF * BK * 2  , STAGE_BYTES = 8 * HTB, NXCD = 8, WGM = 8;

__host__ __device__ __forceinline__ int lds_byte(int r, int c) { const int st = (r >> 4) * 2 + (c >> 5), rr = r & 15, cc = c & 31, ob = rr * 64 + cc * 2; return st * 1024 + (ob ^ (((ob >> 9) & 1) << 5)); }
__host__ __device__ __forceinline__ void stage_rc(int b, int& R, int& C) { const int st = b / 1024, sb = b % 1024, swz = sb ^ (((sb >> 9) & 1) << 5); R = (st >> 1) * 16 + swz / 64; C = (st & 1) * 32 + (swz % 64) / 2; }
__host__ __device__ __forceinline__ int perm32(int rho) { const int n = rho >> 4, i = rho & 15; return 8 * (i >> 2) + 4 * n + (i & 3); }

struct Unit { int pm, pn; };
struct Gemm { const bf16_t* A; const bf16_t* Bt; int M, N, K; };

struct StaticOrder {
    int nM, nN, nwg, G, c;
    __host__ __device__ void init(int M, int N, int G_, int c_) { nM = M / BM; nN = N / BM; nwg = nM * nN; G = G_; c = c_; }
    __host__ __device__ bool next(int i, Unit& u) const {
        const long L = (long)i * G + c; if (L >= nwg) return false;
        int wgid = (int)L; { const int q = nwg / NXCD, r = nwg % NXCD, xcd = wgid % NXCD, off = wgid / NXCD; wgid = (xcd < r ? xcd * (q + 1) : r * (q + 1) + (xcd - r) * q) + off; }
        const int nig = WGM * nN, gid = wgid / nig, fm = gid * WGM, gsz = (nM - fm) < WGM ? (nM - fm) : WGM;
        u.pm = fm + ((wgid % nig) % gsz); u.pn = (wgid % nig) / gsz; return true;
    }
    __device__ __forceinline__ void a_ready(const Unit&) const {}
    __device__ __forceinline__ void done(const Unit&) const {}
};
__device__ __forceinline__ unsigned cvt_pk_bf16(float lo, float hi) { unsigned r; asm volatile("v_cvt_pk_bf16_f32 %0, %1, %2" : "=v"(r) : "v"(lo), "v"(hi)); return r; }
typedef float f32x2 __attribute__((ext_vector_type(2)));
__device__ __forceinline__ float fast_sigmoid(float x) { return __builtin_amdgcn_rcpf(1.0f + __expf(-x)); }
__device__ __forceinline__ float proj_act(float x, int mode, float sc, float lb) {
    if (mode == 0) return x * sc;
    const float s = fast_sigmoid(x);
    if (mode == 1) return x * s * sc;
    const float f = lb + (1.0f - lb) * s;
    return fmaxf(__logf(f), -80.0f);
}
struct EpiProj {
    static constexpr bool PERM = true, AFTER_DRAIN = false;
    bf16_t* O; int ldc; const float* lb; int layerB;
    __device__ __forceinline__ void operator()(const f32x4 (&acc)[2][2][4][2], const Unit& u, int wr, int wc, int fr, int fq) const {
        const int row0 = u.pm * BM + wr * 64 + fr, colt = u.pn * BM, col0 = colt + wc * 32 + 8 * fq;
        int mode = 0; float sc = 1.0f; int lboff = 0;
        if (!layerB) {
            if (u.pn < 12) { mode = 1; sc = 0.08838834764831845f; }
            else if (u.pn < 36) { mode = 2; lboff = (u.pn - 12) * BM; }
            else if (u.pn < 48) { mode = 0; }
            else if (u.pn < 52) { mode = 0; sc = 0.0625f; }
            else { mode = 1; }
        } else {
            if (u.pn < 12) { mode = 0; sc = 0.08838834764831845f; }
            else if (u.pn < 36) { mode = 0; }
            else if (u.pn < 40) { mode = 0; sc = 0.0625f; }
            else { mode = 1; }
        }
        f32x4 lbv[2][2];
#pragma unroll
        for (int bj = 0; bj < 2; ++bj)
#pragma unroll
            for (int n = 0; n < 2; ++n) lbv[bj][n] = (mode == 2) ? *(const f32x4*)(lb + lboff + wc * 32 + 8 * fq + bj * HALF + 4 * n) : (f32x4){0.f, 0.f, 0.f, 0.f};
#pragma unroll
        for (int ai = 0; ai < 2; ++ai)
#pragma unroll
            for (int m = 0; m < 4; ++m) { bf16_t* rowp = O + (size_t)(row0 + ai * HALF + m * 16) * ldc + col0;
#pragma unroll
                for (int bj = 0; bj < 2; ++bj) { f32x4 v0 = acc[ai][bj][m][0], v1 = acc[ai][bj][m][1];
#pragma unroll
                    for (int j = 0; j < 4; ++j) { v0[j] = proj_act(v0[j], mode, sc, lbv[bj][0][j]); v1[j] = proj_act(v1[j], mode, sc, lbv[bj][1][j]); }
                    u32x4 w; w.x = cvt_pk_bf16(v0[0], v0[1]); w.y = cvt_pk_bf16(v0[2], v0[3]); w.z = cvt_pk_bf16(v1[0], v1[1]); w.w = cvt_pk_bf16(v1[2], v1[3]);
                    *(u32x4*)(rowp + bj * HALF) = w; } }
    }
};
struct EpiKV {
    static constexpr bool PERM = true, AFTER_DRAIN = false;
    bf16_t* O; int ldc; int cmask;
    __device__ __forceinline__ void operator()(const f32x4 (&acc)[2][2][4][2], const Unit& u, int wr, int wc, int fr, int fq) const {
        const int row0 = u.pm * BM + wr * 64 + fr, col0 = (u.pn & cmask) * BM + wc * 32 + 8 * fq;
#pragma unroll
        for (int ai = 0; ai < 2; ++ai)
#pragma unroll
            for (int m = 0; m < 4; ++m) { bf16_t* rowp = O + (size_t)(row0 + ai * HALF + m * 16) * ldc + col0;
#pragma unroll
                for (int bj = 0; bj < 2; ++bj) { const f32x4 v0 = acc[ai][bj][m][0], v1 = acc[ai][bj][m][1];
                    u32x4 w; w.x = cvt_pk_bf16(v0[0], v0[1]); w.y = cvt_pk_bf16(v0[2], v0[3]); w.z = cvt_pk_bf16(v1[0], v1[1]); w.w = cvt_pk_bf16(v1[2], v1[3]);
                    *(u32x4*)(rowp + bj * HALF) = w; } }
    }
};
struct EpiResid {
    static constexpr bool PERM = false, AFTER_DRAIN = false;
    const float* base; float* out; int ldc;
    __device__ __forceinline__ void operator()(const f32x4 (&acc)[2][2][4][2], const Unit& u, int wr, int wc, int fr, int fq) const {
        const int row0 = u.pm * BM + wr * 64 + fr, col0 = u.pn * BM + wc * 32 + 4 * fq;
#pragma unroll
        for (int ai = 0; ai < 2; ++ai)
#pragma unroll
            for (int m = 0; m < 4; ++m) { const size_t off = (size_t)(row0 + ai * HALF + m * 16) * ldc + col0;
#pragma unroll
                for (int bj = 0; bj < 2; ++bj)
#pragma unroll
                    for (int n = 0; n < 2; ++n) { const f32x4 b = *(const f32x4*)(base + off + bj * HALF + n * 16); *(f32x4*)(out + off + bj * HALF + n * 16) = b + acc[ai][bj][m][n]; } }
    }
};
struct KvOrder {
    int G, c;
    __device__ __forceinline__ bool next(int i, Unit& u) const {
        const int L = i * G + c; if (L >= 320) return false;
        const int layer = L / 80, rem = L % 80; u.pm = layer * 10 + (rem >> 3); u.pn = layer * 8 + (rem & 7); return true;
    }
    __device__ __forceinline__ void a_ready(const Unit&) const {}
    __device__ __forceinline__ void done(const Unit&) const {}
};
template <class Epi, class Sched, bool ALIGN_EPI = false, bool SP2 = false>
__device__ __forceinline__ void gemm_phase(PG8_LAS unsigned char* lds, const Gemm g, const Sched& S, const Epi& E) {
    int tid_ = threadIdx.x; asm volatile("" : "+v"(tid_)); const int tid = tid_, wid = __builtin_amdgcn_readfirstlane(tid >> 6), lane = tid & 63, wr = wid >> 2, wc = wid & 3, fr = lane & 15, fq = lane >> 4;
    const int K = g.K, nt = K / BK;
    unsigned voffA[2], voffB[2];
#pragma unroll
    for (int i = 0; i < 2; ++i) { int R, C; stage_rc(tid * 16 + i * 8192, R, C); const int Rb = Epi::PERM ? ((R & ~31) + perm32(R & 31)) : R;
        voffA[i] = (unsigned)(R * K + C) * 2u; voffB[i] = (unsigned)(Rb * K + C) * 2u; }
    const size_t kstep = (size_t)(BK * 2);
    const size_t hstep = (size_t)HALF * K * 2;
    const size_t tstep = 2 * hstep;
    const unsigned ldsw = (unsigned)wid * 1024u;
    const int aoff = lds_byte(wr * 64 + fr, fq * 8), boff = lds_byte(wc * 32 + fr, fq * 8);
#define PG8_SA(b, h) (((b) * 2 + (h)) * HTB)
#define PG8_SB(b, h) ((4 + (b) * 2 + (h)) * HTB)
#define PG8_STAGE(bufoff, gbase, voff) do { _Pragma("unroll") for (int _i = 0; _i < 2; ++_i) \
        __builtin_amdgcn_global_load_lds((const unsigned*)((const char*)(gbase) + (voff)[_i]), (PG8_LAS unsigned*)(lds + (bufoff) + ldsw + _i * 8192), 16, 0, 0); } while (0)
#define PG8_LDA(dst, b, h) do { _Pragma("unroll") for (int m = 0; m < 4; ++m) _Pragma("unroll") for (int k = 0; k < 2; ++k) dst[m][k] = *(const PG8_LAS bf16x8*)(lds + PG8_SA(b, h) + aoff + m * 2048 + k * 1024); } while (0)
#define PG8_LDB(dst, b, h) do { _Pragma("unroll") for (int n = 0; n < 2; ++n) _Pragma("unroll") for (int k = 0; k < 2; ++k) dst[n][k] = *(const PG8_LAS bf16x8*)(lds + PG8_SB(b, h) + boff + n * 2048 + k * 1024); } while (0)
#define PG8_MMA(ai, bj, At, Bt) do { __builtin_amdgcn_s_setprio(1); _Pragma("unroll") for (int m = 0; m < 4; ++m) _Pragma("unroll") for (int n = 0; n < 2; ++n) _Pragma("unroll") for (int k = 0; k < 2; ++k) \
        acc[ai][bj][m][n] = __builtin_amdgcn_mfma_f32_16x16x32_bf16(Bt[n][k], At[m][k], acc[ai][bj][m][n], 0, 0, 0); __builtin_amdgcn_s_setprio(0); } while (0)
#define PG8_WAIT_V(n) asm volatile("s_waitcnt vmcnt(" #n ")" ::: "memory")
#define PG8_WAIT_L(n) asm volatile("s_waitcnt lgkmcnt(" #n ")" ::: "memory")
#define PG8_BAR __builtin_amdgcn_s_barrier()
#define PG8_SCHED __builtin_amdgcn_sched_barrier(0)
    Unit cur, nxt; int ui = 0;
    if (!S.next(0, cur)) return;
    f32x4 acc[2][2][4][2];
#pragma unroll
    for (int a = 0; a < 2; ++a)
#pragma unroll
        for (int b = 0; b < 2; ++b)
#pragma unroll
            for (int m = 0; m < 4; ++m)
#pragma unroll
                for (int n = 0; n < 2; ++n) acc[a][b][m][n] = (f32x4){0.f, 0.f, 0.f, 0.f};
    bf16x8 At[4][2], B0[2][2], B1[2][2];
    const char* cA = (const char*)g.A + (size_t)cur.pm * tstep; const char* cB = (const char*)g.Bt + (size_t)cur.pn * tstep;
    S.a_ready(cur);
    if constexpr (SP2) {
        PG8_STAGE(PG8_SB(0, 0), cB, voffB); PG8_STAGE(PG8_SB(0, 1), cB + hstep, voffB); PG8_STAGE(PG8_SA(0, 0), cA, voffA); PG8_STAGE(PG8_SA(0, 1), cA + hstep, voffA);
        if (wr == 1) PG8_BAR;
        PG8_WAIT_V(2); PG8_BAR;
        PG8_STAGE(PG8_SB(1, 0), cB + kstep, voffB); PG8_STAGE(PG8_SA(1, 0), cA + kstep, voffA); PG8_STAGE(PG8_SB(1, 1), cB + hstep + kstep, voffB);
        PG8_WAIT_V(6); PG8_BAR;
    } else {
        PG8_STAGE(PG8_SB(0, 0), cB, voffB); PG8_STAGE(PG8_SA(0, 0), cA, voffA); PG8_STAGE(PG8_SB(0, 1), cB + hstep, voffB); PG8_STAGE(PG8_SA(0, 1), cA + hstep, voffA);
        if (wr == 1) PG8_BAR;
        PG8_WAIT_V(4); PG8_BAR;
        PG8_STAGE(PG8_SB(1, 0), cB + kstep, voffB); PG8_STAGE(PG8_SA(1, 0), cA + kstep, voffA); PG8_STAGE(PG8_SB(1, 1), cB + hstep + kstep, voffB);
        PG8_WAIT_V(6); PG8_BAR;
    }
    for (;;) {
        const bool has_next = S.next(ui + 1, nxt);
        const char* nA = has_next ? (const char*)g.A + (size_t)nxt.pm * tstep : cA; const char* nB = has_next ? (const char*)g.Bt + (size_t)nxt.pn * tstep : cB;
        for (int t = 0; t < nt; t += 2) {
            const bool last = (t == nt - 2);
            const char* a1 = cA + (size_t)(t + 1) * kstep;
            const char* a2 = last ? nA : cA + (size_t)(t + 2) * kstep; const char* b2 = last ? nB : cB + (size_t)(t + 2) * kstep;
            const char* a3 = a2 + kstep; const char* b3 = b2 + kstep;
            if (last && has_next) S.a_ready(nxt);
            if constexpr (SP2) {
            PG8_LDB(B0, 0, 0); PG8_LDB(B1, 0, 1); PG8_SCHED; PG8_LDA(At, 0, 0); PG8_STAGE(PG8_SA(1, 1), a1 + hstep, voffA);
            PG8_WAIT_V(8); PG8_WAIT_L(0); PG8_BAR; PG8_MMA(0, 0, At, B0); PG8_MMA(0, 1, At, B1); PG8_BAR; PG8_SCHED;
            PG8_LDA(At, 0, 1); PG8_STAGE(PG8_SB(0, 0), b2, voffB); PG8_STAGE(PG8_SB(0, 1), b2 + hstep, voffB); PG8_STAGE(PG8_SA(0, 0), a2, voffA);
            PG8_WAIT_V(8); PG8_WAIT_L(0); PG8_BAR; PG8_MMA(1, 0, At, B0); PG8_MMA(1, 1, At, B1); PG8_BAR; PG8_SCHED;
            PG8_LDB(B0, 1, 0); PG8_LDB(B1, 1, 1); PG8_SCHED; PG8_LDA(At, 1, 0); PG8_STAGE(PG8_SA(0, 1), a2 + hstep, voffA);
            PG8_WAIT_V(8); PG8_WAIT_L(0); PG8_BAR; PG8_MMA(0, 0, At, B0); PG8_MMA(0, 1, At, B1); PG8_BAR; PG8_SCHED;
            PG8_LDA(At, 1, 1); PG8_STAGE(PG8_SB(1, 0), b3, voffB); PG8_STAGE(PG8_SB(1, 1), b3 + hstep, voffB); PG8_STAGE(PG8_SA(1, 0), a3, voffA);
            PG8_WAIT_V(8); PG8_WAIT_L(0); PG8_BAR; PG8_MMA(1, 0, At, B0); PG8_MMA(1, 1, At, B1); PG8_BAR; PG8_SCHED;
            } else {
            PG8_LDB(B0, 0, 0); PG8_SCHED; PG8_LDA(At, 0, 0); PG8_STAGE(PG8_SA(1, 1), a1 + hstep, voffA);
            PG8_WAIT_L(8); PG8_BAR; PG8_WAIT_L(0); PG8_MMA(0, 0, At, B0); PG8_BAR; PG8_SCHED;
            PG8_LDB(B1, 0, 1); PG8_STAGE(PG8_SB(0, 0), b2, voffB);
            PG8_BAR; PG8_WAIT_L(0); PG8_MMA(0, 1, At, B1); PG8_BAR;
            PG8_LDA(At, 0, 1); PG8_STAGE(PG8_SA(0, 0), a2, voffA);
            PG8_BAR; PG8_WAIT_L(0); PG8_MMA(1, 0, At, B0); PG8_BAR; PG8_SCHED;
            PG8_STAGE(PG8_SB(0, 1), b2 + hstep, voffB);
            PG8_WAIT_V(6); PG8_BAR; PG8_MMA(1, 1, At, B1); PG8_BAR;
            PG8_LDB(B0, 1, 0); PG8_SCHED; PG8_LDA(At, 1, 0); PG8_STAGE(PG8_SA(0, 1), a2 + hstep, voffA);
            PG8_WAIT_L(8); PG8_BAR; PG8_WAIT_L(0); PG8_MMA(0, 0, At, B0); PG8_BAR; PG8_SCHED;
            PG8_LDB(B1, 1, 1); PG8_STAGE(PG8_SB(1, 0), b3, voffB);
            PG8_BAR; PG8_WAIT_L(0); PG8_MMA(0, 1, At, B1); PG8_BAR;
            PG8_LDA(At, 1, 1); PG8_STAGE(PG8_SA(1, 0), a3, voffA);
            PG8_BAR; PG8_WAIT_L(0); PG8_MMA(1, 0, At, B0); PG8_BAR; PG8_SCHED;
            PG8_STAGE(PG8_SB(1, 1), b3 + hstep, voffB);
            PG8_WAIT_V(6); PG8_BAR; PG8_MMA(1, 1, At, B1); PG8_BAR;
            }
        }
        if constexpr (ALIGN_EPI) { if (wr == 0) PG8_BAR; }
        if constexpr (!Epi::AFTER_DRAIN) { E(acc, cur, wr, wc, fr, fq); S.done(cur); }
        if (!has_next) break;
#pragma unroll
        for (int a = 0; a < 2; ++a)
#pragma unroll
            for (int b = 0; b < 2; ++b)
#pragma unroll
                for (int m = 0; m < 4; ++m)
#pragma unroll
                    for (int n = 0; n < 2; ++n) acc[a][b][m][n] = (f32x4){0.f, 0.f, 0.f, 0.f};
        cur = nxt; cA = nA; cB = nB; ++ui;
        if constexpr (ALIGN_EPI) { if (wr == 1) PG8_BAR; }
    }
    PG8_WAIT_V(0);
    if constexpr (!ALIGN_EPI) { if (wr == 0) PG8_BAR; }
    PG8_BAR;
    if constexpr (Epi::AFTER_DRAIN) { E.fused(acc, cur, wr, wc, fr, fq, lds, wid, lane); S.done(cur); }
#undef PG8_SA
#undef PG8_SB
#undef PG8_STAGE
#undef PG8_LDA
#undef PG8_LDB
#undef PG8_MMA
#undef PG8_WAIT_V
#undef PG8_WAIT_L
#undef PG8_BAR
#undef PG8_SCHED
}
}
#define GAS __attribute__((address_space(1)))
#define LAS __attribute__((address_space(3)))
typedef unsigned short bf16;
typedef unsigned v4u __attribute__((ext_vector_type(4)));
typedef float f32x4 __attribute__((ext_vector_type(4)));
typedef short bf16x8 __attribute__((ext_vector_type(8)));
typedef GAS unsigned gu32;
typedef GAS unsigned long long gu64;
#define RLX_AGENT __ATOMIC_RELAXED, __HIP_MEMORY_SCOPE_AGENT
#define LDS_WAIT() asm volatile("s_waitcnt lgkmcnt(0)" ::: "memory")
#define VM_WAIT() asm volatile("s_waitcnt vmcnt(0)" ::: "memory")
__device__ __forceinline__ unsigned long long rt() { return __builtin_amdgcn_s_memrealtime(); }
__device__ __forceinline__ unsigned f2bf(float f) { unsigned u = __builtin_bit_cast(unsigned, f); return (u + 0x7fffu + ((u >> 16) & 1u)) >> 16; }
__device__ __forceinline__ unsigned pk2(float lo, float hi) { return f2bf(lo) | (f2bf(hi) << 16); }
#define XB_TMO      128
#define XB_XCNT(j)  (256  + 64 * (j))
#define XB_XSUB(j)  (1280 + 64 * (j))
#define XB_XGEN(j)  (2304 + 64 * (j))
#define XB_TOP      3328
#define XB_TOPGEN   3392
#define XCD_BAR_WORDS 3456
#define XB_SPIN_CAP (1u << 22)

__device__ __forceinline__ unsigned xb_ld(unsigned* p)              { return __hip_atomic_load(p, __ATOMIC_RELAXED, __HIP_MEMORY_SCOPE_AGENT); }
__device__ __forceinline__ unsigned xb_add(unsigned* p, unsigned v) { return __hip_atomic_fetch_add(p, v, __ATOMIC_RELAXED, __HIP_MEMORY_SCOPE_AGENT); }
__device__ __forceinline__ unsigned xb_xcc_id() { return (unsigned)__builtin_amdgcn_s_getreg((3 << 11) | 20) & 0xFu; }
#define XB_SPIN(cond, bar) do { unsigned _sp = 0; while (cond) { __builtin_amdgcn_s_sleep(1); \
    if ((++_sp & 255u) == 0u) { if (xb_ld(&(bar)[XB_TMO])) break; if (_sp > XB_SPIN_CAP) { atomicAdd(&(bar)[XB_TMO], 1u); break; } } } } while (0)

struct XcdBarrier {
    unsigned* bar; unsigned x;
    volatile LAS unsigned* st;
};

__device__ __forceinline__ XcdBarrier xcd_barrier_post(unsigned* bar, volatile LAS unsigned* st) {
    XcdBarrier b; b.bar = bar; b.x = xb_xcc_id(); b.st = st;
    if (threadIdx.x == 0) (void)xb_add(&bar[XB_XCNT(b.x)], 1u);
    return b;
}
__device__ __forceinline__ void xcd_barrier_complete(unsigned* bar, unsigned x, unsigned& nloc, unsigned& nx) {
    const unsigned G = gridDim.x * gridDim.y * gridDim.z;
    unsigned sum, cnt, mine, sp = 0u;
    for (;;) {
        sum = 0u; cnt = 0u; mine = 0u;
#pragma unroll
        for (unsigned j = 0; j < 16; ++j) { const unsigned c = xb_ld(&bar[XB_XCNT(j)]); sum += c; cnt += (c > 0u) ? 1u : 0u; mine = (j == x) ? c : mine; }
        if (sum == G) break;
        __builtin_amdgcn_s_sleep(1);
        if ((++sp & 255u) == 0u) { if (xb_ld(&bar[XB_TMO])) break; if (sp > XB_SPIN_CAP) { atomicAdd(&bar[XB_TMO], 1u); break; } }
    }
    nloc = mine > 0u ? mine : 1u; nx = cnt > 0u ? cnt : 1u;
}

__device__ __forceinline__ void xcd_barrier(const XcdBarrier& b) {
    asm volatile("s_waitcnt vmcnt(0)" ::: "memory");
    __syncthreads();
    if (threadIdx.x == 0) {
        unsigned* bar = b.bar;
        __builtin_amdgcn_s_waitcnt(0);
        unsigned nloc = b.st[0], nx = b.st[1];
        if (nloc == 0u) { xcd_barrier_complete(bar, b.x, nloc, nx); b.st[0] = nloc; b.st[1] = nx; }
        const unsigned old = xb_add(&bar[XB_XSUB(b.x)], 1u);
        const unsigned gen = old / nloc;
        if (old + 1u == (gen + 1u) * nloc) {
            __builtin_amdgcn_fence(__ATOMIC_RELEASE, "agent");
            asm volatile("s_waitcnt vmcnt(0)" ::: "memory");
            const unsigned og = xb_add(&bar[XB_TOP], 1u);
            const unsigned tg = og / nx;
            if (og + 1u == (tg + 1u) * nx) xb_add(&bar[XB_TOPGEN], 1u);
            else XB_SPIN(xb_ld(&bar[XB_TOPGEN]) == tg, bar);
            __builtin_amdgcn_fence(__ATOMIC_ACQUIRE, "agent");
            xb_add(&bar[XB_XGEN(b.x)], 1u);
            asm volatile("s_waitcnt vmcnt(0)" ::: "memory");
        } else {
            XB_SPIN(xb_ld(&bar[XB_XGEN(b.x)]) == gen, bar);
            __builtin_amdgcn_fence(__ATOMIC_ACQUIRE, "agent");
            asm volatile("s_waitcnt vmcnt(0)" ::: "memory");
        }
    }
    __syncthreads();
}
constexpr int NWAVES = 8;
constexpr int DM = 2048, SEQ = 4096, NSEQ = 10, NTOK = NSEQ * SEQ, NGRP = 5, GT = NTOK / NGRP  ;
constexpr int P_A = 17408, P_B = 14336, TOKW = 3072, MEMW = 1024, MIXW = 4096, NMEM = 256, NHEAD = 24, HD = 128, MHEADS = 4, MHD = 256;
constexpr int QM_A = 12288, GATE_A = 13312, QM_B = 9216, GATE_B = 10240;
constexpr int NLAYER = 4;
constexpr float EPS = 1e-6f;
constexpr size_t MiB = 1u << 20;
constexpr size_t WS_CTL = 0, CTL_ZERO_BYTES = 1 * MiB;
constexpr size_t WS_LBVEC = 1 * MiB;
constexpr size_t WS_WINA = 2 * MiB;
constexpr size_t WS_WINB = 138 * MiB;
constexpr size_t WS_WOUT = 250 * MiB;
constexpr size_t WS_WKV  = 314 * MiB;
constexpr size_t WS_MEMH = 346 * MiB;
constexpr size_t WS_KV   = 386 * MiB;
constexpr size_t WS_H    = 426 * MiB;
constexpr size_t WS_PROJ = 458 * MiB;
constexpr size_t WS_OG   = 730 * MiB;
constexpr size_t WS_OPART= 794 * MiB;
constexpr size_t WS_END  = 986 * MiB;
constexpr int CW_BAR = 4096;
constexpr int RING_OFF = 0, RING_BYTES = 131072;
constexpr int LDSCTL_OFF = RING_BYTES, MISC_OFF = LDSCTL_OFF + 320;
constexpr int LDS_BYTES = 147456;

struct Args { const float* in[14]; float* out; unsigned char* ws; int s_lo, s_hi; };
struct Frame {
    LAS unsigned char* lds;
    volatile LAS unsigned* MISC;
    int tid, lane, wave, G;
};
typedef const __attribute__((address_space(4))) Args* KArgsP;
__device__ __forceinline__ KArgsP kargs() { KArgsP p = (KArgsP)__builtin_amdgcn_kernarg_segment_ptr(); asm volatile("" : "+s"(p)); return p; }
__device__ __forceinline__ int opq(int x) { asm volatile("" : "+v"(x)); return x; }
#define FIN(k) (kargs()->in[k])
#define FOUT() (kargs()->out)
#define FWS(T, off) ((T*)(kargs()->ws + (off)))

__device__ __forceinline__ float wave_sum(float v) {
#pragma unroll
    for (int o = 1; o < 64; o <<= 1) v += __shfl_xor(v, o);
    return v;
}
__device__ __forceinline__ float wave_max(float v) {
#pragma unroll
    for (int o = 1; o < 64; o <<= 1) v = fmaxf(v, __shfl_xor(v, o));
    return v;
}
__device__ __forceinline__ float bf2f(unsigned short b) { return __uint_as_float(((unsigned)b) << 16); }
__device__ __forceinline__ float bflo(unsigned w) { return __uint_as_float(w << 16); }
__device__ __forceinline__ float bfhi(unsigned w) { return __uint_as_float(w & 0xffff0000u); }

__device__ __forceinline__ void p0_transpose_item(const float* W, int K, int N, bf16* WT, LAS float* scr, int item, int lane) {
    const int nblk = N / 32, kb = item / nblk, nb = item % nblk, k0 = 64 * kb, n0 = 32 * nb;
#pragma unroll 8
    for (int i = 0; i < 32; ++i) { const int kk = 2 * i + (lane >> 5); scr[kk * 33 + (lane & 31)] = W[(size_t)(k0 + kk) * N + n0 + (lane & 31)]; }
    LDS_WAIT(); asm volatile("" ::: "memory");
    const int c = lane & 7;
#pragma unroll
    for (int j = 0; j < 4; ++j) { const int n = (lane >> 3) + 8 * j; const LAS float* s = scr + (8 * c) * 33 + n;
        v4u o; o.x = pk2(s[0 * 33], s[1 * 33]); o.y = pk2(s[2 * 33], s[3 * 33]); o.z = pk2(s[4 * 33], s[5 * 33]); o.w = pk2(s[6 * 33], s[7 * 33]);
        *(GAS v4u*)(WT + (size_t)(n0 + n) * K + k0 + 8 * c) = o; }
    LDS_WAIT(); asm volatile("" ::: "memory");
}
__device__ __forceinline__ void rms_row_bf16(const float* xrow, const float* g, bf16* orow, int lane) {
    const GAS f32x4* xr = (const GAS f32x4*)xrow + lane;
    f32x4 v[8]; float s = 0.f;
#pragma unroll
    for (int j = 0; j < 8; ++j) { v[j] = xr[64 * j]; s += (v[j].x * v[j].x + v[j].y * v[j].y) + (v[j].z * v[j].z + v[j].w * v[j].w); }
    const float r = rsqrtf(wave_sum(s) * (1.f / DM) + EPS);
    const GAS f32x4* gr = (const GAS f32x4*)g + lane;
    GAS unsigned long long* o8 = (GAS unsigned long long*)orow + lane;
#pragma unroll
    for (int j = 0; j < 8; ++j) { const f32x4 gv = gr[64 * j]; const f32x4 y = v[j] * r * gv;
        o8[64 * j] = (unsigned long long)pg8::cvt_pk_bf16(y.x, y.y) | ((unsigned long long)pg8::cvt_pk_bf16(y.z, y.w) << 32); }
}
__device__ __forceinline__ void rms_row_f32_inplace(float* xrow, const float* g, int lane) {
    GAS f32x4* xr = (GAS f32x4*)xrow + lane;
    f32x4 v[8]; float s = 0.f;
#pragma unroll
    for (int j = 0; j < 8; ++j) { v[j] = xr[64 * j]; s += (v[j].x * v[j].x + v[j].y * v[j].y) + (v[j].z * v[j].z + v[j].w * v[j].w); }
    const float r = rsqrtf(wave_sum(s) * (1.f / DM) + EPS);
    const GAS f32x4* gr = (const GAS f32x4*)g + lane;
#pragma unroll
    for (int j = 0; j < 8; ++j) { const f32x4 gv = gr[64 * j]; xr[64 * j] = v[j] * r * gv; }
}
__device__ __forceinline__ const float* x_src_row(const float* xp, const float* xs, const float* out, int layer, int tok) {
    if (layer > 0) return out + (size_t)tok * DM;
    return tok < 2 * SEQ ? xp + (size_t)tok * DM : xs + (size_t)(tok - 2 * SEQ) * DM;
}
__device__ __forceinline__ void p_prologue(const Frame& F0) {
    Frame F = F0; F.tid = opq(F0.tid); F.lane = F.tid & 63; F.wave = __builtin_amdgcn_readfirstlane(F.tid >> 6);
    const float *memp = FIN(2), *mems = FIN(3), *w_in_a = FIN(4), *w_in_b = FIN(5), *w_kv = FIN(6), *w_out = FIN(7), *mem_norm_g = FIN(9), *lb_logits = FIN(10);
    float* lbvec = FWS(float, WS_LBVEC); bf16 *WINA = FWS(bf16, WS_WINA), *WINB = FWS(bf16, WS_WINB), *WOUT = FWS(bf16, WS_WOUT), *WKV = FWS(bf16, WS_WKV), *MEMH = FWS(bf16, WS_MEMH);
    LAS float* scr = (LAS float*)(F.lds + RING_OFF + F.wave * 16384);
    const int gw = blockIdx.x * NWAVES + F.wave, NGW = F.G * NWAVES;
    constexpr int I_A = (DM / 64) * (P_A / 32), I_B = (DM / 64) * (P_B / 32), I_O = (MIXW / 64) * (DM / 32), I_K = (DM / 64) * (2048 / 32);
    constexpr int NITEMS = 2 * I_A + 2 * I_B + 4 * I_O + 4 * I_K;
    for (int it = gw; it < NITEMS; it += NGW) {
        int r = it;
        if (r < 2 * I_A) { const int a = r / I_A; p0_transpose_item(w_in_a + (size_t)a * DM * P_A, DM, P_A, WINA + (size_t)a * P_A * DM, scr, r % I_A, F.lane); continue; } r -= 2 * I_A;
        if (r < 2 * I_B) { const int a = r / I_B; p0_transpose_item(w_in_b + (size_t)a * DM * P_B, DM, P_B, WINB + (size_t)a * P_B * DM, scr, r % I_B, F.lane); continue; } r -= 2 * I_B;
        if (r < 4 * I_O) { const int a = r / I_O; p0_transpose_item(w_out + (size_t)a * MIXW * DM, MIXW, DM, WOUT + (size_t)a * DM * MIXW, scr, r % I_O, F.lane); continue; } r -= 4 * I_O;
        { const int a = r / I_K; p0_transpose_item(w_kv + (size_t)a * DM * 2048, DM, 2048, WKV + (size_t)a * 2048 * DM, scr, r % I_K, F.lane); }
    }
    for (int i = (blockIdx.x * NWAVES + F.wave) * 64 + F.lane; i < 2 * 6144; i += NGW * 64) {
        float v = 0.f;
        if (i >= 6144) { const int c = i - 6144; const float l0 = lb_logits[c], l1 = lb_logits[6144 + c]; v = 1.0f / (1.0f + expf(l0 - l1)); }
        lbvec[i] = v;
    }
    for (int it = gw; it < NLAYER * 2560; it += NGW) { const int i = it / 2560, m = it % 2560;
        const float* src = m < 512 ? memp + (size_t)m * DM : mems + (size_t)(m - 512) * DM;
        rms_row_bf16(src, mem_norm_g + i * DM, MEMH + (size_t)it * DM, F.lane); }
}
__device__ __forceinline__ void p_norm(const Frame& F0, int layer, int g) {
    Frame F = F0; F.tid = opq(F0.tid); F.lane = F.tid & 63; F.wave = __builtin_amdgcn_readfirstlane(F.tid >> 6);
    const float *xp = FIN(0), *xs = FIN(1), *norm_g = FIN(8); const float* out = FOUT(); bf16* H = FWS(bf16, WS_H);
    const int gw = blockIdx.x * NWAVES + F.wave, NGW = F.G * NWAVES;
    for (int t = gw; t < GT; t += NGW) rms_row_bf16(x_src_row(xp, xs, out, layer, g * GT + t), norm_g + layer * DM, H + (size_t)t * DM, F.lane);
}
__device__ __forceinline__ void p_final(const Frame& F0) {
    Frame F = F0; F.tid = opq(F0.tid); F.lane = F.tid & 63; F.wave = __builtin_amdgcn_readfirstlane(F.tid >> 6);
    const float* final_g = FIN(13); float* out = FOUT();
    const int gw = blockIdx.x * NWAVES + F.wave, NGW = F.G * NWAVES;
    for (int t = gw; t < NTOK; t += NGW) rms_row_f32_inplace(out + (size_t)t * DM, final_g, F.lane);
}

__device__ __forceinline__ void scan_naive(Frame& F, int u) {
    const bf16* PROJ = FWS(bf16, WS_PROJ); float* OPART = FWS(float, WS_OPART);
    const int dir = u / 48, sl = (u % 48) / 24, head = u % 24;
    LAS float* qs_l = (LAS float*)(F.lds + RING_OFF);
    LAS float* f_l = qs_l + 4096; LAS float* k_l = f_l + 4096; LAS float* v_l = k_l + 4096; LAS float* op_l = v_l + 4096;
    const int tid = F.tid, v = tid & 127, dg = tid >> 7, lr = tid >> 4, lc = (tid & 15) * 8;
    const bf16* proj = PROJ + (size_t)(sl * SEQ) * P_A;
    float* opart = OPART + ((size_t)dir * GT + sl * SEQ) * TOKW + head * HD;
    float S[32];
#pragma unroll
    for (int i = 0; i < 32; ++i) S[i] = 0.f;
    for (int c = 0; c < SEQ / 32; ++c) {
        const int idx = 32 * c + lr, t = dir ? (SEQ - 1 - idx) : idx;
        { const bf16* row = proj + (size_t)t * P_A;
          const bf16x8 q8 = *(const GAS bf16x8*)(row + head * HD + lc);
          const bf16x8 g8 = *(const GAS bf16x8*)(row + TOKW + dir * TOKW + head * HD + lc);
          const bf16x8 v8 = *(const GAS bf16x8*)(row + 3 * TOKW + head * HD + lc);
#pragma unroll
          for (int j = 0; j < 8; ++j) { const int o = lr * 128 + lc + j; const float ff = __expf(bf2f((unsigned short)g8[j]));
              qs_l[o] = bf2f((unsigned short)q8[j]); f_l[o] = ff; k_l[o] = 1.0f - ff; v_l[o] = bf2f((unsigned short)v8[j]); } }
        __syncthreads();
        for (int r = 0; r < 32; ++r) {
            const float vv = v_l[r * 128 + v]; float acc = 0.f;
            const LAS f32x4* fp = (const LAS f32x4*)(f_l + r * 128 + dg * 32); const LAS f32x4* kp = (const LAS f32x4*)(k_l + r * 128 + dg * 32); const LAS f32x4* qp = (const LAS f32x4*)(qs_l + r * 128 + dg * 32);
#pragma unroll
            for (int i4 = 0; i4 < 8; ++i4) { const f32x4 f4 = fp[i4], k4 = kp[i4], q4 = qp[i4];
#pragma unroll
                for (int j = 0; j < 4; ++j) { S[i4 * 4 + j] = f4[j] * S[i4 * 4 + j] + k4[j] * vv; acc += S[i4 * 4 + j] * q4[j]; } }
            op_l[(r * 4 + dg) * 128 + v] = acc;
        }
        __syncthreads();
        { f32x4 o0, o1;
#pragma unroll
          for (int j = 0; j < 4; ++j) { o0[j] = (op_l[(lr * 4 + 0) * 128 + lc + j] + op_l[(lr * 4 + 1) * 128 + lc + j]) + (op_l[(lr * 4 + 2) * 128 + lc + j] + op_l[(lr * 4 + 3) * 128 + lc + j]);
              o1[j] = (op_l[(lr * 4 + 0) * 128 + lc + 4 + j] + op_l[(lr * 4 + 1) * 128 + lc + 4 + j]) + (op_l[(lr * 4 + 2) * 128 + lc + 4 + j] + op_l[(lr * 4 + 3) * 128 + lc + 4 + j]); }
          GAS f32x4* op = (GAS f32x4*)(opart + (size_t)t * TOKW + lc); op[0] = o0; op[1] = o1; }
        __syncthreads();
    }
}
__device__ __forceinline__ void combine_naive(const Frame& F0, int a) {
    Frame F = F0; F.tid = opq(F0.tid); F.lane = F.tid & 63; F.wave = __builtin_amdgcn_readfirstlane(F.tid >> 6);
    const bf16* PROJ = FWS(bf16, WS_PROJ); const float* OPART = FWS(float, WS_OPART); bf16* OG = FWS(bf16, WS_OG); const float* onorm_g = FIN(11);
    const int gw = blockIdx.x * NWAVES + F.wave, NGW = F.G * NWAVES, lane = F.lane;
    for (int it = gw; it < GT * NHEAD; it += NGW) { const int tau = it / NHEAD, head = it % NHEAD; const int col = head * HD + 2 * lane;
        const float* p0 = OPART + (size_t)tau * TOKW + col; const float* p1 = OPART + ((size_t)GT + tau) * TOKW + col;
        const float o0 = p0[0] + p1[0], o1 = p0[1] + p1[1];
        const float rs = rsqrtf(wave_sum(o0 * o0 + o1 * o1) * (1.0f / HD) + EPS);
        const unsigned sg = *(const GAS unsigned*)(PROJ + (size_t)tau * P_A + GATE_A + col);
        const float g0 = onorm_g[a * TOKW + col], g1 = onorm_g[a * TOKW + col + 1];
        *(GAS unsigned*)(OG + (size_t)tau * MIXW + col) = pg8::cvt_pk_bf16(o0 * rs * g0 * bflo(sg), o1 * rs * g1 * bfhi(sg)); }
}
__device__ __forceinline__ void na_naive_item(Frame& F, const bf16* PROJ, bf16* OG, const float* rpb, int bi, int tau, int head) {
    const int lane = F.lane; LAS float* qsh = (LAS float*)(F.lds + RING_OFF) + F.wave * 512; LAS float* psh = qsh + 256;
    const int sl = tau >> 12, t = tau & 4095, r = t >> 6, c = t & 63;
    const int rs = min(max(r - 4, 0), 56), cs = min(max(c - 8, 0), 48);
    { const unsigned w = *(const GAS unsigned*)(PROJ + (size_t)tau * P_B + head * HD + 2 * lane); qsh[2 * lane] = bflo(w); qsh[2 * lane + 1] = bfhi(w); }
    LDS_WAIT(); asm volatile("" ::: "memory");
    float s[2];
#pragma unroll
    for (int jj = 0; jj < 2; ++jj) { const int n = lane + 64 * jj, j = n >> 4, i = n & 15; const int ktok = sl * SEQ + (rs + j) * 64 + cs + i;
        const bf16* krow = PROJ + (size_t)ktok * P_B + TOKW + head * HD; float dot = 0.f;
        for (int d8 = 0; d8 < 16; ++d8) { const bf16x8 k8 = *(const GAS bf16x8*)(krow + d8 * 8); const f32x4 qa = *(const LAS f32x4*)(qsh + d8 * 8), qb = *(const LAS f32x4*)(qsh + d8 * 8 + 4);
#pragma unroll
            for (int e = 0; e < 4; ++e) { dot += qa[e] * bf2f((unsigned short)k8[e]); dot += qb[e] * bf2f((unsigned short)k8[4 + e]); } }
        s[jj] = dot + rpb[((size_t)(bi * NHEAD + head) * 15 + (rs + j - r + 7)) * 31 + (cs + i - c + 15)]; }
    const float m = wave_max(fmaxf(s[0], s[1])); const float e0 = __expf(s[0] - m), e1 = __expf(s[1] - m); const float inv = 1.0f / wave_sum(e0 + e1);
    psh[lane] = e0 * inv; psh[lane + 64] = e1 * inv;
    LDS_WAIT(); asm volatile("" ::: "memory");
    float a0 = 0.f, a1 = 0.f;
    for (int n = 0; n < 128; ++n) { const int j = n >> 4, i = n & 15; const int ktok = sl * SEQ + (rs + j) * 64 + cs + i;
        const unsigned w = *(const GAS unsigned*)(PROJ + (size_t)ktok * P_B + 2 * TOKW + head * HD + 2 * lane); const float p = psh[n]; a0 += p * bflo(w); a1 += p * bfhi(w); }
    const unsigned sg = *(const GAS unsigned*)(PROJ + (size_t)tau * P_B + GATE_B + head * HD + 2 * lane);
    *(GAS unsigned*)(OG + (size_t)tau * MIXW + head * HD + 2 * lane) = pg8::cvt_pk_bf16(a0 * bflo(sg), a1 * bfhi(sg));
    LDS_WAIT(); asm volatile("" ::: "memory");
}
__device__ __forceinline__ void mem_naive_item(Frame& F, const bf16* PROJ, bf16* OG, const bf16* KV, int layer, int g, int tau, int mh) {
    const int lane = F.lane; LAS float* qsh = (LAS float*)(F.lds + RING_OFF) + F.wave * 512; LAS float* psh = qsh + 256;
    const int P = (layer & 1) ? P_B : P_A, QM = (layer & 1) ? QM_B : QM_A, GATE = (layer & 1) ? GATE_B : GATE_A;
    const int seq = g * 2 + (tau >> 12);
    const bf16* kv = KV + ((size_t)layer * 2560 + seq * NMEM) * 2048;
    { const unsigned long long w = *(const GAS unsigned long long*)(PROJ + (size_t)tau * P + QM + mh * MHD + 4 * lane);
      qsh[4 * lane] = bflo((unsigned)w); qsh[4 * lane + 1] = bfhi((unsigned)w); qsh[4 * lane + 2] = bflo((unsigned)(w >> 32)); qsh[4 * lane + 3] = bfhi((unsigned)(w >> 32)); }
    LDS_WAIT(); asm volatile("" ::: "memory");
    float s[4];
#pragma unroll
    for (int jj = 0; jj < 4; ++jj) { const int m = lane + 64 * jj; const bf16* krow = kv + (size_t)m * 2048 + mh * MHD; float dot = 0.f;
        for (int d8 = 0; d8 < 32; ++d8) { const bf16x8 k8 = *(const GAS bf16x8*)(krow + d8 * 8); const f32x4 qa = *(const LAS f32x4*)(qsh + d8 * 8), qb = *(const LAS f32x4*)(qsh + d8 * 8 + 4);
#pragma unroll
            for (int e = 0; e < 4; ++e) { dot += qa[e] * bf2f((unsigned short)k8[e]); dot += qb[e] * bf2f((unsigned short)k8[4 + e]); } }
        s[jj] = dot; }
    const float mx = wave_max(fmaxf(fmaxf(s[0], s[1]), fmaxf(s[2], s[3])));
    float e[4]; float es = 0.f;
#pragma unroll
    for (int jj = 0; jj < 4; ++jj) { e[jj] = __expf(s[jj] - mx); es += e[jj]; }
    const float inv = 1.0f / wave_sum(es);
#pragma unroll
    for (int jj = 0; jj < 4; ++jj) psh[lane + 64 * jj] = e[jj] * inv;
    LDS_WAIT(); asm volatile("" ::: "memory");
    float a0 = 0.f, a1 = 0.f, a2 = 0.f, a3 = 0.f;
    for (int m = 0; m < NMEM; ++m) { const unsigned long long w = *(const GAS unsigned long long*)(kv + (size_t)m * 2048 + MEMW + mh * MHD + 4 * lane); const float p = psh[m];
        a0 += p * bflo((unsigned)w); a1 += p * bfhi((unsigned)w); a2 += p * bflo((unsigned)(w >> 32)); a3 += p * bfhi((unsigned)(w >> 32)); }
    const unsigned long long sg = *(const GAS unsigned long long*)(PROJ + (size_t)tau * P + GATE + TOKW + mh * MHD + 4 * lane);
    const unsigned lo = pg8::cvt_pk_bf16(a0 * bflo((unsigned)sg), a1 * bfhi((unsigned)sg)), hi = pg8::cvt_pk_bf16(a2 * bflo((unsigned)(sg >> 32)), a3 * bfhi((unsigned)(sg >> 32)));
    *(GAS unsigned long long*)(OG + (size_t)tau * MIXW + TOKW + mh * MHD + 4 * lane) = (unsigned long long)lo | ((unsigned long long)hi << 32);
    LDS_WAIT(); asm volatile("" ::: "memory");
}
__device__ __forceinline__ void p_mix_naive(const Frame& F0, int layer, int g) {
    Frame F = F0; F.tid = opq(F0.tid); F.lane = F.tid & 63; F.wave = __builtin_amdgcn_readfirstlane(F.tid >> 6);
    const bf16* PROJ = FWS(bf16, WS_PROJ); bf16* OG = FWS(bf16, WS_OG); const bf16* KV = FWS(bf16, WS_KV); const float* rpb = FIN(12);
    const int gw = blockIdx.x * NWAVES + F.wave, NGW = F.G * NWAVES;
    if (!(layer & 1)) {
        if (blockIdx.x < 96) scan_naive(F, (int)blockIdx.x);
        for (int it = gw; it < GT * MHEADS; it += NGW) mem_naive_item(F, PROJ, OG, KV, layer, g, it >> 2, it & 3);
    } else {
        for (int it = gw; it < GT * NHEAD; it += NGW) na_naive_item(F, PROJ, OG, rpb, layer >> 1, it / NHEAD, it % NHEAD);
        for (int it = gw; it < GT * MHEADS; it += NGW) mem_naive_item(F, PROJ, OG, KV, layer, g, it >> 2, it & 3);
    }
}

__global__ void __launch_bounds__(NWAVES * 64, 2) fwd(Args args) {
    extern __shared__ __attribute__((aligned(16))) unsigned char lds[];
    Frame F;
    F.lds = (LAS unsigned char*)lds;
    F.MISC = (volatile LAS unsigned*)(F.lds + MISC_OFF);
    F.tid = threadIdx.x; F.lane = F.tid & 63; F.wave = __builtin_amdgcn_readfirstlane(F.tid >> 6); F.G = gridDim.x;
    for (int u = F.tid; u < (LDS_BYTES - LDSCTL_OFF) / 4; u += NWAVES * 64) ((LAS unsigned*)(F.lds + LDSCTL_OFF))[u] = 0u;
    __syncthreads();
    XcdBarrier bar = xcd_barrier_post(FWS(unsigned, WS_CTL) + CW_BAR, F.MISC + 8);
    const int s_lo = args.s_lo, s_hi = args.s_hi;
    int step = 0;
#define IN_STEP() (step >= s_lo && step < s_hi)
#define SEAM() do { if (step >= s_lo && step + 1 < s_hi) xcd_barrier(bar); ++step; } while (0)

    if (IN_STEP()) { p_prologue(F); p_norm(F, 0, 0); }
    SEAM();
    if (IN_STEP()) {
        pg8::Gemm gm{FWS(bf16, WS_MEMH), FWS(bf16, WS_WKV), NLAYER * 2560, 2048, DM}; pg8::KvOrder S{F.G, (int)blockIdx.x}; pg8::EpiKV E{FWS(bf16, WS_KV), 2048, 7};
        pg8::gemm_phase<pg8::EpiKV, pg8::KvOrder, true, true>(F.lds + RING_OFF, gm, S, E);
    }
    for (int layer = 0; layer < NLAYER; ++layer) {
        const int isB = layer & 1, P = isB ? P_B : P_A;
        for (int g = 0; g < NGRP; ++g) {
            if (IN_STEP()) {
                const bf16* Bt = isB ? FWS(bf16, WS_WINB) + (size_t)(layer >> 1) * P_B * DM : FWS(bf16, WS_WINA) + (size_t)(layer >> 1) * P_A * DM;
                pg8::Gemm gm{FWS(bf16, WS_H), Bt, GT, P, DM}; pg8::StaticOrder S; S.init(GT, P, F.G, (int)blockIdx.x);
                pg8::EpiProj E{FWS(bf16, WS_PROJ), P, FWS(float, WS_LBVEC) + (layer >> 1) * 6144, isB};
                pg8::gemm_phase<pg8::EpiProj, pg8::StaticOrder, true, true>(F.lds + RING_OFF, gm, S, E);
            }
            SEAM();
            if (IN_STEP()) p_mix_naive(F, layer, g);
            SEAM();
            if (IN_STEP()) { if (!isB) combine_naive(F, layer >> 1); }
            SEAM();
            if (IN_STEP()) {
                float* out = FOUT(); const float* base = layer > 0 ? out + (size_t)g * GT * DM : (g == 0 ? FIN(0) : FIN(1) + (size_t)(g - 1) * GT * DM);
                pg8::Gemm gm{FWS(bf16, WS_OG), FWS(bf16, WS_WOUT) + (size_t)layer * DM * MIXW, GT, DM, MIXW}; pg8::StaticOrder S; S.init(GT, DM, F.G, (int)blockIdx.x);
                pg8::EpiResid E{base, out + (size_t)g * GT * DM, DM};
                pg8::gemm_phase<pg8::EpiResid, pg8::StaticOrder, true, true>(F.lds + RING_OFF, gm, S, E);
                if (g + 1 < NGRP) p_norm(F, layer, g + 1); else if (layer + 1 < NLAYER) p_norm(F, layer + 1, 0);
            }
            SEAM();
        }
    }
    if (IN_STEP()) p_final(F);
#undef IN_STEP
#undef SEAM
}

#ifndef MK_MULTI
#define MK_MULTI 0
#endif
extern "C" void kernel_launch(void* const* d_in, const int* in_sizes, int n_in, void* d_out, int out_size, void* d_ws, size_t ws_size, hipStream_t stream) {
    static int grid = 0;
    if (grid == 0) {
        if (n_in != 14 || out_size != NTOK * DM || ws_size < WS_END) { fprintf(stderr, "kernel_launch: unexpected shapes: n_in %d out %d ws %zu (need %zu)\n", n_in, out_size, ws_size, (size_t)WS_END); grid = -1; return; }
        int dev = 0, cus = 0, per_cu = 0;
        if (hipGetDevice(&dev) != hipSuccess || hipDeviceGetAttribute(&cus, hipDeviceAttributeMultiprocessorCount, dev) != hipSuccess) { grid = -1; return; }
        if (hipFuncSetAttribute((const void*)fwd, hipFuncAttributeMaxDynamicSharedMemorySize, LDS_BYTES) != hipSuccess) { fprintf(stderr, "kernel_launch: hipFuncSetAttribute failed\n"); grid = -1; return; }
        if (hipOccupancyMaxActiveBlocksPerMultiprocessor(&per_cu, (const void*)fwd, NWAVES * 64, LDS_BYTES) != hipSuccess || per_cu < 1) { fprintf(stderr, "kernel_launch: occupancy query says %d\n", per_cu); }
        (void)hipGetLastError();
        grid = cus;
    }
    if (grid < 0) return;
    if (hipMemsetAsync((char*)d_ws + WS_CTL, 0, CTL_ZERO_BYTES, stream) != hipSuccess) return;
    Args a{};
    for (int i = 0; i < 14; ++i) a.in[i] = (const float*)d_in[i];
    a.out = (float*)d_out; a.ws = (unsigned char*)d_ws;
    constexpr int NSTEPS = 2 + NLAYER * NGRP * 4;
    if (MK_MULTI) {
        for (int s = 0; s < NSTEPS; ++s) { a.s_lo = s; a.s_hi = s + 1; hipLaunchKernelGGL(fwd, dim3(grid), dim3(NWAVES * 64), LDS_BYTES, stream, a); }
    } else {
        a.s_lo = 0; a.s_hi = 1 << 30; hipLaunchKernelGGL(fwd, dim3(grid), dim3(NWAVES * 64), LDS_BYTES, stream, a);
    }
    const hipError_t le = hipPeekAtLastError();
    if (le != hipSuccess) fprintf(stderr, "kernel_launch: launch failed: %s\n", hipGetErrorName(le));
}
```

```cpp
#include <hip/hip_runtime.h>
#include <cstdio>
#include <cstdint>
namespace pg8 {
#define PG8_LAS __attribute__((address_space(3)))
typedef unsigned short bf16_t;
typedef short bf16x8 __attribute__((ext_vector_type(8)));
typedef float f32x4 __attribute__((ext_vector_type(4)));
typedef unsigned u32x4 __attribute__((ext_vector_type(4)));
constexpr int BM = 256, BK = 64, HALF = 128, HTB = HALF * BK * 2  , STAGE_BYTES = 8 * HTB, NXCD = 8, WGM = 4;

__host__ __device__ __forceinline__ int lds_byte(int r, int c) { const int st = (r >> 4) * 2 + (c >> 5), rr = r & 15, cc = c & 31, ob = rr * 64 + cc * 2; return st * 1024 + (ob ^ (((ob >> 9) & 1) << 5)); }
__host__ __device__ __forceinline__ void stage_rc(int b, int& R, int& C) { const int st = b / 1024, sb = b % 1024, swz = sb ^ (((sb >> 9) & 1) << 5); R = (st >> 1) * 16 + swz / 64; C = (st & 1) * 32 + (swz % 64) / 2; }
__host__ __device__ __forceinline__ int perm32(int rho) { const int n = rho >> 4, i = rho & 15; return 8 * (i >> 2) + 4 * n + (i & 3); }

struct Unit { int pm, pn; };
struct Gemm { const bf16_t* A; const bf16_t* Bt; int M, N, K; };

struct StaticOrder {
    int nM, nN, nwg, G, c;
    __host__ __device__ void init(int M, int N, int G_, int c_) { nM = M / BM; nN = N / BM; nwg = nM * nN; G = G_; c = c_; }
    __host__ __device__ bool next(int i, Unit& u) const {
        const long L = (long)i * G + c; if (L >= nwg) return false;
        int wgid = (int)L; { const int q = nwg / NXCD, r = nwg % NXCD, xcd = wgid % NXCD, off = wgid / NXCD; wgid = (xcd < r ? xcd * (q + 1) : r * (q + 1) + (xcd - r) * q) + off; }
        const int nig = WGM * nN, gid = wgid / nig, fm = gid * WGM, gsz = (nM - fm) < WGM ? (nM - fm) : WGM;
        u.pm = fm + ((wgid % nig) % gsz); u.pn = (wgid % nig) / gsz; return true;
    }
    __device__ __forceinline__ void a_ready(const Unit&) const {}
    __device__ __forceinline__ void done(const Unit&) const {}
};
typedef __bf16 bf16v2_t __attribute__((ext_vector_type(2)));
__device__ __forceinline__ unsigned cvt_pk_bf16(float lo, float hi) { bf16v2_t v; v.x = (__bf16)lo; v.y = (__bf16)hi; return __builtin_bit_cast(unsigned, v); }
typedef float f32x2 __attribute__((ext_vector_type(2)));
__device__ __forceinline__ float fast_sigmoid(float x) { return __builtin_amdgcn_rcpf(1.0f + __expf(-x)); }
__device__ __forceinline__ float proj_act(float x, int mode, float sc, float lb) {
    if (mode == 0) return x * sc;
    const float s = fast_sigmoid(x);
    if (mode == 1) return x * s * sc;
    const float f = lb + (1.0f - lb) * s;
    return fmaxf(__logf(f), -80.0f);
}
struct EpiProj {
    static constexpr bool PERM = true, AFTER_DRAIN = false;
    bf16_t* O; int ldc; const float* lb; int layerB; bf16_t* HB; int hm_tiles, tm_col0, hm_rows;
    __device__ __forceinline__ void operator()(const f32x4 (&acc)[2][2][4][2], const Unit& u, int wr, int wc, int fr, int fq) const {
        const int row0 = u.pm * BM + wr * 64 + fr;
        int mode = 0; float sc = 1.0f; int lboff = 0;
        if (!layerB) {
            if (u.pn < 12) { mode = 1; sc = 0.08838834764831845f; }
            else if (u.pn < 36) { mode = 2; lboff = (u.pn - 12) * BM; }
            else if (u.pn < 48) { mode = 0; }
            else if (u.pn < 52) { mode = 0; sc = 0.0625f; }
            else { mode = 1; }
        } else {
            if (u.pn < 12) { mode = 0; sc = 0.12751743074602254f; }
            else if (u.pn < 36) { mode = 0; }
            else if (u.pn < 40) { mode = 0; sc = 0.0625f; }
            else { mode = 1; }
        }
        bf16_t* sb; size_t rstr, bjstr;
        if (u.pn < hm_tiles) { sb = HB + (size_t)(2 * u.pn) * hm_rows * 128 + wc * 32 + 8 * fq; rstr = 128; bjstr = (size_t)hm_rows * 128; }
        else { sb = O + (u.pn * BM - tm_col0) + wc * 32 + 8 * fq; rstr = (size_t)ldc; bjstr = HALF; }
        if (mode == 2) {
            f32x4 lbv[2][2];
#pragma unroll
            for (int bj = 0; bj < 2; ++bj)
#pragma unroll
                for (int n = 0; n < 2; ++n) lbv[bj][n] = *(const f32x4*)(lb + lboff + wc * 32 + 8 * fq + bj * HALF + 4 * n);
#pragma unroll
            for (int ai = 0; ai < 2; ++ai)
#pragma unroll
                for (int m = 0; m < 4; ++m) { bf16_t* rowp = sb + (size_t)(row0 + ai * HALF + m * 16) * rstr;
#pragma unroll
                    for (int bj = 0; bj < 2; ++bj) { f32x4 v0 = acc[ai][bj][m][0], v1 = acc[ai][bj][m][1];
#pragma unroll
                        for (int j = 0; j < 4; ++j) { v0[j] = proj_act(v0[j], 2, 1.0f, lbv[bj][0][j]); v1[j] = proj_act(v1[j], 2, 1.0f, lbv[bj][1][j]); }
                        u32x4 w; w.x = cvt_pk_bf16(v0[0], v0[1]); w.y = cvt_pk_bf16(v0[2], v0[3]); w.z = cvt_pk_bf16(v1[0], v1[1]); w.w = cvt_pk_bf16(v1[2], v1[3]);
                        *(u32x4*)(rowp + bj * bjstr) = w; } }
        } else if (mode == 1) {
#pragma unroll
            for (int ai = 0; ai < 2; ++ai)
#pragma unroll
                for (int m = 0; m < 4; ++m) { bf16_t* rowp = sb + (size_t)(row0 + ai * HALF + m * 16) * rstr;
#pragma unroll
                    for (int bj = 0; bj < 2; ++bj) { f32x4 v0 = acc[ai][bj][m][0], v1 = acc[ai][bj][m][1];
#pragma unroll
                        for (int j = 0; j < 4; ++j) { v0[j] = proj_act(v0[j], 1, sc, 0.f); v1[j] = proj_act(v1[j], 1, sc, 0.f); }
                        u32x4 w; w.x = cvt_pk_bf16(v0[0], v0[1]); w.y = cvt_pk_bf16(v0[2], v0[3]); w.z = cvt_pk_bf16(v1[0], v1[1]); w.w = cvt_pk_bf16(v1[2], v1[3]);
                        *(u32x4*)(rowp + bj * bjstr) = w; } }
        } else {
#pragma unroll
            for (int ai = 0; ai < 2; ++ai)
#pragma unroll
                for (int m = 0; m < 4; ++m) { bf16_t* rowp = sb + (size_t)(row0 + ai * HALF + m * 16) * rstr;
#pragma unroll
                    for (int bj = 0; bj < 2; ++bj) { const f32x4 v0 = acc[ai][bj][m][0] * sc, v1 = acc[ai][bj][m][1] * sc;
                        u32x4 w; w.x = cvt_pk_bf16(v0[0], v0[1]); w.y = cvt_pk_bf16(v0[2], v0[3]); w.z = cvt_pk_bf16(v1[0], v1[1]); w.w = cvt_pk_bf16(v1[2], v1[3]);
                        *(u32x4*)(rowp + bj * bjstr) = w; } }
        }
    }
};
struct EpiKV {
    static constexpr bool PERM = true, AFTER_DRAIN = false;
    bf16_t* O; int ldc; int cmask;
    __device__ __forceinline__ void operator()(const f32x4 (&acc)[2][2][4][2], const Unit& u, int wr, int wc, int fr, int fq) const {
        const int row0 = u.pm * BM + wr * 64 + fr, col0 = (u.pn & cmask) * BM + wc * 32 + 8 * fq;
#pragma unroll
        for (int ai = 0; ai < 2; ++ai)
#pragma unroll
            for (int m = 0; m < 4; ++m) { bf16_t* rowp = O + (size_t)(row0 + ai * HALF + m * 16) * ldc + col0;
#pragma unroll
                for (int bj = 0; bj < 2; ++bj) { const f32x4 v0 = acc[ai][bj][m][0], v1 = acc[ai][bj][m][1];
                    u32x4 w; w.x = cvt_pk_bf16(v0[0], v0[1]); w.y = cvt_pk_bf16(v0[2], v0[3]); w.z = cvt_pk_bf16(v1[0], v1[1]); w.w = cvt_pk_bf16(v1[2], v1[3]);
                    *(u32x4*)(rowp + bj * HALF) = w; } }
    }
};
struct EpiResid {
    static constexpr bool PERM = false, AFTER_DRAIN = false;
    const float* base; float* out; int ldc;
    __device__ __forceinline__ void operator()(const f32x4 (&acc)[2][2][4][2], const Unit& u, int wr, int wc, int fr, int fq) const {
        const int row0 = u.pm * BM + wr * 64 + fr, col0 = u.pn * BM + wc * 32 + 4 * fq;
#pragma unroll
        for (int ai = 0; ai < 2; ++ai)
#pragma unroll
            for (int m = 0; m < 4; ++m) { const size_t off = (size_t)(row0 + ai * HALF + m * 16) * ldc + col0;
#pragma unroll
                for (int bj = 0; bj < 2; ++bj)
#pragma unroll
                    for (int n = 0; n < 2; ++n) { const f32x4 b = *(const f32x4*)(base + off + bj * HALF + n * 16); *(f32x4*)(out + off + bj * HALF + n * 16) = b + acc[ai][bj][m][n]; } }
    }
};
struct KvOrder {
    int G, c;
    __device__ __forceinline__ bool next(int i, Unit& u) const {
        const int L = i * G + c; if (L >= 320) return false;
        const int layer = L / 80, rem = L % 80; u.pm = layer * 10 + (rem >> 3); u.pn = layer * 8 + (rem & 7); return true;
    }
    __device__ __forceinline__ void a_ready(const Unit&) const {}
    __device__ __forceinline__ void done(const Unit&) const {}
};
struct ShiftOrder {
    int nM, nN, nwg, G, c, shift, width;
    __device__ __forceinline__ void init(int M, int N, int G_, int c_, int shift_, int width_) { nM = M / BM; nN = N / BM; nwg = nM * nN; G = G_; c = c_; shift = shift_; width = width_; }
    __device__ __forceinline__ bool next(int i, Unit& u) const {
        const int R = nwg / G; long L;
        if (i < R) L = (long)i * G + c;
        else if (width == 0) { L = (long)i * G + c; if (L >= nwg) return false; }
        else { if (c < shift || c >= shift + width) return false; L = (long)R * G + (long)(i - R) * width + (c - shift); if (L >= nwg) return false; }
        int wgid = (int)L; { const int q = nwg / NXCD, r = nwg % NXCD, xcd = wgid % NXCD, off = wgid / NXCD; wgid = (xcd < r ? xcd * (q + 1) : r * (q + 1) + (xcd - r) * q) + off; }
        const int nig = WGM * nN, gid = wgid / nig, fm = gid * WGM, gsz = (nM - fm) < WGM ? (nM - fm) : WGM;
        u.pm = fm + ((wgid % nig) % gsz); u.pn = (wgid % nig) / gsz; return true;
    }
    __device__ __forceinline__ void a_ready(const Unit&) const {}
    __device__ __forceinline__ void done(const Unit&) const {}
};
template <class Epi, class Sched, bool ALIGN_EPI = false, bool SP2 = false>
__device__ __forceinline__ void gemm_phase(PG8_LAS unsigned char* lds, const Gemm g, const Sched& S, const Epi& E, int wave_in) {
    int lane_; asm volatile("v_mbcnt_lo_u32_b32 %0, -1, 0\n\tv_mbcnt_hi_u32_b32 %0, -1, %0" : "=v"(lane_)); const int tid = wave_in * 64 + lane_, wid = __builtin_amdgcn_readfirstlane(tid >> 6), lane = tid & 63, wr = wid >> 2, wc = wid & 3, fr = lane & 15, fq = lane >> 4;
    const int K = g.K, nt = K / BK;
    unsigned voffA[2], voffB[2];
#pragma unroll
    for (int i = 0; i < 2; ++i) { int R, C; stage_rc(tid * 16 + i * 8192, R, C); const int Rb = Epi::PERM ? ((R & ~31) + perm32(R & 31)) : R;
        voffA[i] = (unsigned)(R * K + C) * 2u; voffB[i] = (unsigned)(Rb * K + C) * 2u; }
    const size_t kstep = (size_t)(BK * 2);
    const size_t hstep = (size_t)HALF * K * 2;
    const size_t tstep = 2 * hstep;
    const unsigned ldsw = (unsigned)wid * 1024u;
    const int aoff = lds_byte(wr * 64 + fr, fq * 8), boff = lds_byte(wc * 32 + fr, fq * 8);
#define PG8_SA(b, h) (((b) * 2 + (h)) * HTB)
#define PG8_SB(b, h) ((4 + (b) * 2 + (h)) * HTB)
#define PG8_STAGE(bufoff, gbase, voff) do { _Pragma("unroll") for (int _i = 0; _i < 2; ++_i) \
        __builtin_amdgcn_global_load_lds((const unsigned*)((const char*)(gbase) + (voff)[_i]), (PG8_LAS unsigned*)(lds + (bufoff) + ldsw + _i * 8192), 16, 0, 0); } while (0)
#define PG8_LDA(dst, b, h) do { _Pragma("unroll") for (int m = 0; m < 4; ++m) _Pragma("unroll") for (int k = 0; k < 2; ++k) dst[m][k] = *(const PG8_LAS bf16x8*)(lds + PG8_SA(b, h) + aoff + m * 2048 + k * 1024); } while (0)
#define PG8_LDB(dst, b, h) do { _Pragma("unroll") for (int n = 0; n < 2; ++n) _Pragma("unroll") for (int k = 0; k < 2; ++k) dst[n][k] = *(const PG8_LAS bf16x8*)(lds + PG8_SB(b, h) + boff + n * 2048 + k * 1024); } while (0)
#define PG8_MMA(ai, bj, At, Bt) do { __builtin_amdgcn_s_setprio(1); _Pragma("unroll") for (int m = 0; m < 4; ++m) _Pragma("unroll") for (int n = 0; n < 2; ++n) _Pragma("unroll") for (int k = 0; k < 2; ++k) \
        acc[ai][bj][m][n] = __builtin_amdgcn_mfma_f32_16x16x32_bf16(Bt[n][k], At[m][k], acc[ai][bj][m][n], 0, 0, 0); __builtin_amdgcn_s_setprio(0); } while (0)
#define PG8_WAIT_V(n) asm volatile("s_waitcnt vmcnt(" #n ")" ::: "memory")
#define PG8_WAIT_L(n) asm volatile("s_waitcnt lgkmcnt(" #n ")" ::: "memory")
#define PG8_BAR __builtin_amdgcn_s_barrier()
#define PG8_SCHED __builtin_amdgcn_sched_barrier(0)
    Unit cur, nxt; int ui = 0;
    if (!S.next(0, cur)) return;
    f32x4 acc[2][2][4][2];
#pragma unroll
    for (int a = 0; a < 2; ++a)
#pragma unroll
        for (int b = 0; b < 2; ++b)
#pragma unroll
            for (int m = 0; m < 4; ++m)
#pragma unroll
                for (int n = 0; n < 2; ++n) acc[a][b][m][n] = (f32x4){0.f, 0.f, 0.f, 0.f};
    bf16x8 At[4][2], B0[2][2], B1[2][2];
    const char* cA = (const char*)g.A + (size_t)cur.pm * tstep; const char* cB = (const char*)g.Bt + (size_t)cur.pn * tstep;
    S.a_ready(cur);
    if constexpr (SP2) {
        PG8_STAGE(PG8_SB(0, 0), cB, voffB); PG8_STAGE(PG8_SB(0, 1), cB + hstep, voffB); PG8_STAGE(PG8_SA(0, 0), cA, voffA); PG8_STAGE(PG8_SA(0, 1), cA + hstep, voffA);
        if (wr == 1) PG8_BAR;
        PG8_WAIT_V(2); PG8_BAR;
        PG8_STAGE(PG8_SB(1, 0), cB + kstep, voffB); PG8_STAGE(PG8_SA(1, 0), cA + kstep, voffA); PG8_STAGE(PG8_SB(1, 1), cB + hstep + kstep, voffB);
        PG8_WAIT_V(6); PG8_BAR;
    } else {
        PG8_STAGE(PG8_SB(0, 0), cB, voffB); PG8_STAGE(PG8_SA(0, 0), cA, voffA); PG8_STAGE(PG8_SB(0, 1), cB + hstep, voffB); PG8_STAGE(PG8_SA(0, 1), cA + hstep, voffA);
        if (wr == 1) PG8_BAR;
        PG8_WAIT_V(4); PG8_BAR;
        PG8_STAGE(PG8_SB(1, 0), cB + kstep, voffB); PG8_STAGE(PG8_SA(1, 0), cA + kstep, voffA); PG8_STAGE(PG8_SB(1, 1), cB + hstep + kstep, voffB);
        PG8_WAIT_V(6); PG8_BAR;
    }
    for (;;) {
        const bool has_next = S.next(ui + 1, nxt);
        const char* nA = has_next ? (const char*)g.A + (size_t)nxt.pm * tstep : cA; const char* nB = has_next ? (const char*)g.Bt + (size_t)nxt.pn * tstep : cB;
        for (int t = 0; t < nt; t += 2) {
            const bool last = (t == nt - 2);
            const char* a1 = cA + (size_t)(t + 1) * kstep;
            const char* a2 = last ? nA : cA + (size_t)(t + 2) * kstep; const char* b2 = last ? nB : cB + (size_t)(t + 2) * kstep;
            const char* a3 = a2 + kstep; const char* b3 = b2 + kstep;
            if (last && has_next) S.a_ready(nxt);
            if constexpr (SP2) {
            PG8_LDB(B0, 0, 0); PG8_LDB(B1, 0, 1); PG8_SCHED; PG8_LDA(At, 0, 0); PG8_STAGE(PG8_SA(1, 1), a1 + hstep, voffA);
            PG8_WAIT_V(8); PG8_WAIT_L(0); PG8_BAR; PG8_MMA(0, 0, At, B0); PG8_MMA(0, 1, At, B1); PG8_BAR; PG8_SCHED;
            PG8_LDA(At, 0, 1); PG8_STAGE(PG8_SB(0, 0), b2, voffB); PG8_STAGE(PG8_SB(0, 1), b2 + hstep, voffB); PG8_STAGE(PG8_SA(0, 0), a2, voffA);
            PG8_WAIT_V(8); PG8_WAIT_L(0); PG8_BAR; PG8_MMA(1, 0, At, B0); PG8_MMA(1, 1, At, B1); PG8_BAR; PG8_SCHED;
            PG8_LDB(B0, 1, 0); PG8_LDB(B1, 1, 1); PG8_SCHED; PG8_LDA(At, 1, 0); PG8_STAGE(PG8_SA(0, 1), a2 + hstep, voffA);
            PG8_WAIT_V(8); PG8_WAIT_L(0); PG8_BAR; PG8_MMA(0, 0, At, B0); PG8_MMA(0, 1, At, B1); PG8_BAR; PG8_SCHED;
            PG8_LDA(At, 1, 1); PG8_STAGE(PG8_SB(1, 0), b3, voffB); PG8_STAGE(PG8_SB(1, 1), b3 + hstep, voffB); PG8_STAGE(PG8_SA(1, 0), a3, voffA);
            PG8_WAIT_V(8); PG8_WAIT_L(0); PG8_BAR; PG8_MMA(1, 0, At, B0); PG8_MMA(1, 1, At, B1); PG8_BAR; PG8_SCHED;
            } else {
            PG8_LDB(B0, 0, 0); PG8_SCHED; PG8_LDA(At, 0, 0); PG8_STAGE(PG8_SA(1, 1), a1 + hstep, voffA);
            PG8_WAIT_L(8); PG8_BAR; PG8_WAIT_L(0); PG8_MMA(0, 0, At, B0); PG8_BAR; PG8_SCHED;
            PG8_LDB(B1, 0, 1); PG8_STAGE(PG8_SB(0, 0), b2, voffB);
            PG8_BAR; PG8_WAIT_L(0); PG8_MMA(0, 1, At, B1); PG8_BAR;
            PG8_LDA(At, 0, 1); PG8_STAGE(PG8_SA(0, 0), a2, voffA);
            PG8_BAR; PG8_WAIT_L(0); PG8_MMA(1, 0, At, B0); PG8_BAR; PG8_SCHED;
            PG8_STAGE(PG8_SB(0, 1), b2 + hstep, voffB);
            PG8_WAIT_V(6); PG8_BAR; PG8_MMA(1, 1, At, B1); PG8_BAR;
            PG8_LDB(B0, 1, 0); PG8_SCHED; PG8_LDA(At, 1, 0); PG8_STAGE(PG8_SA(0, 1), a2 + hstep, voffA);
            PG8_WAIT_L(8); PG8_BAR; PG8_WAIT_L(0); PG8_MMA(0, 0, At, B0); PG8_BAR; PG8_SCHED;
            PG8_LDB(B1, 1, 1); PG8_STAGE(PG8_SB(1, 0), b3, voffB);
            PG8_BAR; PG8_WAIT_L(0); PG8_MMA(0, 1, At, B1); PG8_BAR;
            PG8_LDA(At, 1, 1); PG8_STAGE(PG8_SA(1, 0), a3, voffA);
            PG8_BAR; PG8_WAIT_L(0); PG8_MMA(1, 0, At, B0); PG8_BAR; PG8_SCHED;
            PG8_STAGE(PG8_SB(1, 1), b3 + hstep, voffB);
            PG8_WAIT_V(6); PG8_BAR; PG8_MMA(1, 1, At, B1); PG8_BAR;
            }
        }
        if constexpr (ALIGN_EPI) { if (wr == 0) PG8_BAR; }
        if constexpr (!Epi::AFTER_DRAIN) { E(acc, cur, wr, wc, fr, fq); S.done(cur); }
        if (!has_next) break;
#pragma unroll
        for (int a = 0; a < 2; ++a)
#pragma unroll
            for (int b = 0; b < 2; ++b)
#pragma unroll
                for (int m = 0; m < 4; ++m)
#pragma unroll
                    for (int n = 0; n < 2; ++n) acc[a][b][m][n] = (f32x4){0.f, 0.f, 0.f, 0.f};
        cur = nxt; cA = nA; cB = nB; ++ui;
        if constexpr (ALIGN_EPI) { if (wr == 1) PG8_BAR; }
    }
    PG8_WAIT_V(0);
    if constexpr (!ALIGN_EPI) { if (wr == 0) PG8_BAR; }
    PG8_BAR;
    if constexpr (Epi::AFTER_DRAIN) { E.fused(acc, cur, wr, wc, fr, fq, lds, wid, lane); S.done(cur); }
#undef PG8_SA
#undef PG8_SB
#undef PG8_STAGE
#undef PG8_LDA
#undef PG8_LDB
#undef PG8_MMA
#undef PG8_WAIT_V
#undef PG8_WAIT_L
#undef PG8_BAR
#undef PG8_SCHED
}
}
#define GAS __attribute__((address_space(1)))
#define LAS __attribute__((address_space(3)))
typedef unsigned short bf16;
typedef unsigned v4u __attribute__((ext_vector_type(4)));
typedef float f32x4 __attribute__((ext_vector_type(4)));
typedef short bf16x8 __attribute__((ext_vector_type(8)));
typedef GAS unsigned gu32;
typedef GAS unsigned long long gu64;
#define RLX_AGENT __ATOMIC_RELAXED, __HIP_MEMORY_SCOPE_AGENT
#define LDS_WAIT() asm volatile("s_waitcnt lgkmcnt(0)" ::: "memory")
#define VM_WAIT() asm volatile("s_waitcnt vmcnt(0)" ::: "memory")
__device__ __forceinline__ unsigned long long rt() { return __builtin_amdgcn_s_memrealtime(); }
__device__ __forceinline__ unsigned f2bf(float f) { unsigned u = __builtin_bit_cast(unsigned, f); return (u + 0x7fffu + ((u >> 16) & 1u)) >> 16; }
__device__ __forceinline__ unsigned pk2(float lo, float hi) { return f2bf(lo) | (f2bf(hi) << 16); }
#define XB_TMO      128
#define XB_XCNT(j)  (256  + 64 * (j))
#define XB_XSUB(j)  (1280 + 64 * (j))
#define XB_XGEN(j)  (2304 + 64 * (j))
#define XB_TOP      3328
#define XB_TOPGEN   3392
#define XCD_BAR_WORDS 3456
#define XB_SPIN_CAP (1u << 22)

__device__ __forceinline__ unsigned xb_ld(unsigned* p)              { return __hip_atomic_load(p, __ATOMIC_RELAXED, __HIP_MEMORY_SCOPE_AGENT); }
__device__ __forceinline__ unsigned xb_add(unsigned* p, unsigned v) { return __hip_atomic_fetch_add(p, v, __ATOMIC_RELAXED, __HIP_MEMORY_SCOPE_AGENT); }
__device__ __forceinline__ unsigned xb_xcc_id() { return (unsigned)__builtin_amdgcn_s_getreg((3 << 11) | 20) & 0xFu; }
#define XB_SPIN(cond, bar) do { unsigned _sp = 0; while (cond) { __builtin_amdgcn_s_sleep(1); \
    if ((++_sp & 255u) == 0u) { if (xb_ld(&(bar)[XB_TMO])) break; if (_sp > XB_SPIN_CAP) { atomicAdd(&(bar)[XB_TMO], 1u); break; } } } } while (0)

struct XcdBarrier {
    unsigned* bar; unsigned x;
    volatile LAS unsigned* st;
};

__device__ __forceinline__ XcdBarrier xcd_barrier_post(unsigned* bar, volatile LAS unsigned* st) {
    XcdBarrier b; b.bar = bar; b.x = xb_xcc_id(); b.st = st;
    if (threadIdx.x == 0) (void)xb_add(&bar[XB_XCNT(b.x)], 1u);
    return b;
}
__device__ __forceinline__ void xcd_barrier_complete(unsigned* bar, unsigned x, unsigned& nloc, unsigned& nx) {
    const unsigned G = gridDim.x * gridDim.y * gridDim.z;
    unsigned sum, cnt, mine, sp = 0u;
    for (;;) {
        sum = 0u; cnt = 0u; mine = 0u;
#pragma unroll
        for (unsigned j = 0; j < 16; ++j) { const unsigned c = xb_ld(&bar[XB_XCNT(j)]); sum += c; cnt += (c > 0u) ? 1u : 0u; mine = (j == x) ? c : mine; }
        if (sum == G) break;
        __builtin_amdgcn_s_sleep(1);
        if ((++sp & 255u) == 0u) { if (xb_ld(&bar[XB_TMO])) break; if (sp > XB_SPIN_CAP) { atomicAdd(&bar[XB_TMO], 1u); break; } }
    }
    nloc = mine > 0u ? mine : 1u; nx = cnt > 0u ? cnt : 1u;
}

__device__ __forceinline__ void xcd_barrier(const XcdBarrier& b) {
    asm volatile("s_waitcnt vmcnt(0)" ::: "memory");
    __syncthreads();
    if (threadIdx.x == 0) {
        unsigned* bar = b.bar;
        __builtin_amdgcn_s_waitcnt(0);
        unsigned nloc = b.st[0], nx = b.st[1];
        if (nloc == 0u) { xcd_barrier_complete(bar, b.x, nloc, nx); b.st[0] = nloc; b.st[1] = nx; }
        const unsigned old = xb_add(&bar[XB_XSUB(b.x)], 1u);
        const unsigned gen = old / nloc;
        if (old + 1u == (gen + 1u) * nloc) {
            __builtin_amdgcn_fence(__ATOMIC_RELEASE, "agent");
            asm volatile("s_waitcnt vmcnt(0)" ::: "memory");
            const unsigned og = xb_add(&bar[XB_TOP], 1u);
            const unsigned tg = og / nx;
            if (og + 1u == (tg + 1u) * nx) xb_add(&bar[XB_TOPGEN], 1u);
            else XB_SPIN(xb_ld(&bar[XB_TOPGEN]) == tg, bar);
            __builtin_amdgcn_fence(__ATOMIC_ACQUIRE, "agent");
            xb_add(&bar[XB_XGEN(b.x)], 1u);
            asm volatile("s_waitcnt vmcnt(0)" ::: "memory");
        } else {
            XB_SPIN(xb_ld(&bar[XB_XGEN(b.x)]) == gen, bar);
            __builtin_amdgcn_fence(__ATOMIC_ACQUIRE, "agent");
            asm volatile("s_waitcnt vmcnt(0)" ::: "memory");
        }
    }
    __syncthreads();
}
constexpr int NWAVES = 8;
constexpr int DM = 2048, SEQ = 4096, NSEQ = 10, NTOK = NSEQ * SEQ, NGRP = 5, GT = NTOK / NGRP  ;
constexpr int P_A = 17408, P_B = 14336, TOKW = 3072, MEMW = 1024, MIXW = 4096, NMEM = 256, NHEAD = 24, HD = 128, MHEADS = 4, MHD = 256;
constexpr int QM_A = 12288, GATE_A = 13312, QM_B = 9216, GATE_B = 10240;
constexpr int NLAYER = 4;
constexpr float EPS = 1e-6f;
constexpr size_t MiB = 1u << 20;
constexpr size_t WS_CTL = 0, CTL_ZERO_BYTES = 1 * MiB;
constexpr size_t WS_LBVEC = 1 * MiB;
constexpr size_t WS_WINA = 2 * MiB;
constexpr size_t WS_WINB = 138 * MiB;
constexpr size_t WS_WOUT = 250 * MiB;
constexpr size_t WS_WKV  = 314 * MiB;
constexpr size_t WS_MEMH = 346 * MiB;
constexpr size_t WS_KV   = 386 * MiB;
constexpr size_t WS_H    = 426 * MiB;
constexpr size_t WS_PROJ = 458 * MiB;
constexpr size_t WS_OG   = 730 * MiB;
constexpr size_t WS_OPART= 794 * MiB;
constexpr size_t WS_OG2  = 986 * MiB;
constexpr size_t WS_END  = 1050 * MiB;
constexpr int CW_BAR = 4096;
constexpr int RING_OFF = 0, RING_BYTES = 131072;
constexpr int LDSCTL_OFF = RING_BYTES, MISC_OFF = LDSCTL_OFF + 320;
constexpr int LDS_BYTES = 147456;

struct Args { const float* in[14]; float* out; unsigned char* ws; int s_lo, s_hi; };
struct Frame {
    LAS unsigned char* lds;
    volatile LAS unsigned* MISC;
    int tid, lane, wave, G;
};
typedef const __attribute__((address_space(4))) Args* KArgsP;
__device__ __forceinline__ KArgsP kargs() { KArgsP p = (KArgsP)__builtin_amdgcn_kernarg_segment_ptr(); asm volatile("" : "+s"(p)); return p; }
__device__ __forceinline__ int lane_id_fresh() { int l; asm volatile("v_mbcnt_lo_u32_b32 %0, -1, 0\n\tv_mbcnt_hi_u32_b32 %0, -1, %0" : "=v"(l)); return l; }
__device__ __forceinline__ int opqs(int x) { asm volatile("" : "+s"(x)); return x; }
#define FIN(k) (kargs()->in[k])
#define FOUT() (kargs()->out)
#define FWS(T, off) ((T*)(kargs()->ws + (off)))
#define OGBUF(item) ((item) & 1 ? FWS(bf16, WS_OG2) : FWS(bf16, WS_OG))

__device__ __forceinline__ float wave_sum(float v) {
#pragma unroll
    for (int o = 1; o < 64; o <<= 1) v += __shfl_xor(v, o);
    return v;
}
__device__ __forceinline__ float wave_max(float v) {
#pragma unroll
    for (int o = 1; o < 64; o <<= 1) v = fmaxf(v, __shfl_xor(v, o));
    return v;
}
__device__ __forceinline__ float bf2f(unsigned short b) { return __uint_as_float(((unsigned)b) << 16); }
__device__ __forceinline__ float bflo(unsigned w) { return __uint_as_float(w << 16); }
__device__ __forceinline__ float bfhi(unsigned w) { return __uint_as_float(w & 0xffff0000u); }

__device__ __forceinline__ void p0_transpose_item(const float* W, int K, int N, bf16* WT, LAS float* scr, int item, int lane) {
    const int nblk = N / 32, kb = item / nblk, nb = item % nblk, k0 = 64 * kb, n0 = 32 * nb;
#pragma unroll 8
    for (int i = 0; i < 32; ++i) { const int kk = 2 * i + (lane >> 5); scr[kk * 33 + (lane & 31)] = W[(size_t)(k0 + kk) * N + n0 + (lane & 31)]; }
    LDS_WAIT(); asm volatile("" ::: "memory");
    const int c = lane & 7;
#pragma unroll
    for (int j = 0; j < 4; ++j) { const int n = (lane >> 3) + 8 * j; const LAS float* s = scr + (8 * c) * 33 + n;
        v4u o; o.x = pk2(s[0 * 33], s[1 * 33]); o.y = pk2(s[2 * 33], s[3 * 33]); o.z = pk2(s[4 * 33], s[5 * 33]); o.w = pk2(s[6 * 33], s[7 * 33]);
        *(GAS v4u*)(WT + (size_t)(n0 + n) * K + k0 + 8 * c) = o; }
    LDS_WAIT(); asm volatile("" ::: "memory");
}
__device__ __forceinline__ void rms_row_bf16(const float* xrow, const float* g, bf16* orow, int lane) {
    const GAS f32x4* xr = (const GAS f32x4*)xrow + lane;
    f32x4 v[8]; float s = 0.f;
#pragma unroll
    for (int j = 0; j < 8; ++j) { v[j] = xr[64 * j]; s += (v[j].x * v[j].x + v[j].y * v[j].y) + (v[j].z * v[j].z + v[j].w * v[j].w); }
    const float r = rsqrtf(wave_sum(s) * (1.f / DM) + EPS);
    const GAS f32x4* gr = (const GAS f32x4*)g + lane;
    GAS unsigned long long* o8 = (GAS unsigned long long*)orow + lane;
#pragma unroll
    for (int j = 0; j < 8; ++j) { const f32x4 gv = gr[64 * j]; const f32x4 y = v[j] * r * gv;
        o8[64 * j] = (unsigned long long)pg8::cvt_pk_bf16(y.x, y.y) | ((unsigned long long)pg8::cvt_pk_bf16(y.z, y.w) << 32); }
}
__device__ __forceinline__ void rms_row_f32_inplace(float* xrow, const float* g, int lane) {
    GAS f32x4* xr = (GAS f32x4*)xrow + lane;
    f32x4 v[8]; float s = 0.f;
#pragma unroll
    for (int j = 0; j < 8; ++j) { v[j] = xr[64 * j]; s += (v[j].x * v[j].x + v[j].y * v[j].y) + (v[j].z * v[j].z + v[j].w * v[j].w); }
    const float r = rsqrtf(wave_sum(s) * (1.f / DM) + EPS);
    const GAS f32x4* gr = (const GAS f32x4*)g + lane;
#pragma unroll
    for (int j = 0; j < 8; ++j) { const f32x4 gv = gr[64 * j]; xr[64 * j] = v[j] * r * gv; }
}
__device__ __forceinline__ const float* x_src_row(const float* xp, const float* xs, const float* out, int layer, int tok) {
    if (layer > 0) return out + (size_t)tok * DM;
    return tok < 2 * SEQ ? xp + (size_t)tok * DM : xs + (size_t)(tok - 2 * SEQ) * DM;
}
__device__ __forceinline__ void p_prologue(const Frame& F0) {
    Frame F = F0; F.lane = lane_id_fresh(); F.tid = F.wave * 64 + F.lane;
    const float *memp = FIN(2), *mems = FIN(3), *w_in_a = FIN(4), *w_in_b = FIN(5), *w_kv = FIN(6), *w_out = FIN(7), *mem_norm_g = FIN(9), *lb_logits = FIN(10);
    float* lbvec = FWS(float, WS_LBVEC); bf16 *WINA = FWS(bf16, WS_WINA), *WINB = FWS(bf16, WS_WINB), *WOUT = FWS(bf16, WS_WOUT), *WKV = FWS(bf16, WS_WKV), *MEMH = FWS(bf16, WS_MEMH);
    LAS float* scr = (LAS float*)(F.lds + RING_OFF + F.wave * 16384);
    const int gw = blockIdx.x * NWAVES + F.wave, NGW = F.G * NWAVES;
    constexpr int I_A = (DM / 64) * (P_A / 32), I_B = (DM / 64) * (P_B / 32), I_O = (MIXW / 64) * (DM / 32), I_K = (DM / 64) * (2048 / 32);
    constexpr int NITEMS = 2 * I_A + 2 * I_B + 4 * I_O + 4 * I_K;
    for (int it = gw; it < NITEMS; it += NGW) {
        int r = it;
        if (r < 2 * I_A) { const int a = r / I_A; p0_transpose_item(w_in_a + (size_t)a * DM * P_A, DM, P_A, WINA + (size_t)a * P_A * DM, scr, r % I_A, F.lane); continue; } r -= 2 * I_A;
        if (r < 2 * I_B) { const int a = r / I_B; p0_transpose_item(w_in_b + (size_t)a * DM * P_B, DM, P_B, WINB + (size_t)a * P_B * DM, scr, r % I_B, F.lane); continue; } r -= 2 * I_B;
        if (r < 4 * I_O) { const int a = r / I_O; p0_transpose_item(w_out + (size_t)a * MIXW * DM, MIXW, DM, WOUT + (size_t)a * DM * MIXW, scr, r % I_O, F.lane); continue; } r -= 4 * I_O;
        { const int a = r / I_K; p0_transpose_item(w_kv + (size_t)a * DM * 2048, DM, 2048, WKV + (size_t)a * 2048 * DM, scr, r % I_K, F.lane); }
    }
    for (int i = (blockIdx.x * NWAVES + F.wave) * 64 + F.lane; i < 2 * 6144; i += NGW * 64) {
        float v = 0.f;
        if (i >= 6144) { const int c = i - 6144; const float l0 = lb_logits[c], l1 = lb_logits[6144 + c]; v = 1.0f / (1.0f + expf(l0 - l1)); }
        lbvec[i] = v;
    }
    for (int it = gw; it < NLAYER * 2560; it += NGW) { const int i = it / 2560, m = it % 2560;
        const float* src = m < 512 ? memp + (size_t)m * DM : mems + (size_t)(m - 512) * DM;
        rms_row_bf16(src, mem_norm_g + i * DM, MEMH + (size_t)it * DM, F.lane); }
}
__device__ __forceinline__ void p_norm(const Frame& F0, int layer, int g, int wg0) {
    Frame F = F0; F.lane = lane_id_fresh(); F.tid = F.wave * 64 + F.lane;
    const float *xp = FIN(0), *xs = FIN(1), *norm_g = FIN(8); const float* out = FOUT(); bf16* H = FWS(bf16, WS_H);
    if ((int)blockIdx.x < wg0) return;
    const int gw = ((int)blockIdx.x - wg0) * NWAVES + F.wave, NGW = (F.G - wg0) * NWAVES;
    for (int t = gw; t < GT; t += NGW) rms_row_bf16(x_src_row(xp, xs, out, layer, g * GT + t), norm_g + layer * DM, H + (size_t)t * DM, F.lane);
}
__device__ __forceinline__ void p_final(const Frame& F0) {
    Frame F = F0; F.lane = lane_id_fresh(); F.tid = F.wave * 64 + F.lane;
    const float* final_g = FIN(13); float* out = FOUT();
    const int gw = blockIdx.x * NWAVES + F.wave, NGW = F.G * NWAVES;
    for (int t = gw; t < NTOK; t += NGW) rms_row_f32_inplace(out + (size_t)t * DM, final_g, F.lane);
}

#ifndef USE_SCAN_OPT
#define USE_SCAN_OPT 1
#endif
#ifndef USE_ATTN_OPT
#define USE_ATTN_OPT 1
#endif
__device__ __forceinline__ void scan_naive(Frame& F, int u) {
    const bf16* PROJ = FWS(bf16, WS_PROJ); float* OPART = FWS(float, WS_OPART);
    const int dir = u / 48, sl = (u % 48) / 24, head = u % 24;
    LAS float* qs_l = (LAS float*)(F.lds + RING_OFF);
    LAS float* f_l = qs_l + 4096; LAS float* k_l = f_l + 4096; LAS float* v_l = k_l + 4096; LAS float* op_l = v_l + 4096;
    const int tid = F.tid, v = tid & 127, dg = tid >> 7, lr = tid >> 4, lc = (tid & 15) * 8;
    const bf16* proj = PROJ + (size_t)(sl * SEQ) * P_A;
    float* opart = OPART + ((size_t)dir * GT + sl * SEQ) * TOKW + head * HD;
    float S[32];
#pragma unroll
    for (int i = 0; i < 32; ++i) S[i] = 0.f;
    for (int c = 0; c < SEQ / 32; ++c) {
        const int idx = 32 * c + lr, t = dir ? (SEQ - 1 - idx) : idx;
        { const bf16* row = proj + (size_t)t * P_A;
          const bf16x8 q8 = *(const GAS bf16x8*)(row + head * HD + lc);
          const bf16x8 g8 = *(const GAS bf16x8*)(row + TOKW + dir * TOKW + head * HD + lc);
          const bf16x8 v8 = *(const GAS bf16x8*)(row + 3 * TOKW + head * HD + lc);
#pragma unroll
          for (int j = 0; j < 8; ++j) { const int o = lr * 128 + lc + j; const float ff = __expf(bf2f((unsigned short)g8[j]));
              qs_l[o] = bf2f((unsigned short)q8[j]); f_l[o] = ff; k_l[o] = 1.0f - ff; v_l[o] = bf2f((unsigned short)v8[j]); } }
        __syncthreads();
        for (int r = 0; r < 32; ++r) {
            const float vv = v_l[r * 128 + v]; float acc = 0.f;
            const LAS f32x4* fp = (const LAS f32x4*)(f_l + r * 128 + dg * 32); const LAS f32x4* kp = (const LAS f32x4*)(k_l + r * 128 + dg * 32); const LAS f32x4* qp = (const LAS f32x4*)(qs_l + r * 128 + dg * 32);
#pragma unroll
            for (int i4 = 0; i4 < 8; ++i4) { const f32x4 f4 = fp[i4], k4 = kp[i4], q4 = qp[i4];
#pragma unroll
                for (int j = 0; j < 4; ++j) { S[i4 * 4 + j] = f4[j] * S[i4 * 4 + j] + k4[j] * vv; acc += S[i4 * 4 + j] * q4[j]; } }
            op_l[(r * 4 + dg) * 128 + v] = acc;
        }
        __syncthreads();
        { f32x4 o0, o1;
#pragma unroll
          for (int j = 0; j < 4; ++j) { o0[j] = (op_l[(lr * 4 + 0) * 128 + lc + j] + op_l[(lr * 4 + 1) * 128 + lc + j]) + (op_l[(lr * 4 + 2) * 128 + lc + j] + op_l[(lr * 4 + 3) * 128 + lc + j]);
              o1[j] = (op_l[(lr * 4 + 0) * 128 + lc + 4 + j] + op_l[(lr * 4 + 1) * 128 + lc + 4 + j]) + (op_l[(lr * 4 + 2) * 128 + lc + 4 + j] + op_l[(lr * 4 + 3) * 128 + lc + 4 + j]); }
          GAS f32x4* op = (GAS f32x4*)(opart + (size_t)t * TOKW + lc); op[0] = o0; op[1] = o1; }
        __syncthreads();
    }
}
constexpr int SC_QM = 0, SC_KM = 8192, SC_QE = 16384, SC_KT = 24576, SC_VT = 34816, SC_EL = 45056, SC_DIR = 46080, SC_RS = 80;
typedef float f32x16 __attribute__((ext_vector_type(16)));
typedef float f32x2v __attribute__((ext_vector_type(2)));
typedef unsigned long long u64;
__device__ __forceinline__ float ex2(float x) { return __builtin_amdgcn_exp2f(x); }
__device__ __forceinline__ bf16x8 mk8(unsigned a, unsigned b, unsigned c, unsigned d) { v4u w = {a, b, c, d}; return __builtin_bit_cast(bf16x8, w); }
__device__ __forceinline__ bf16x8 mk8q(u64 lo, u64 hi) { v4u w = {(unsigned)lo, (unsigned)(lo >> 32), (unsigned)hi, (unsigned)(hi >> 32)}; return __builtin_bit_cast(bf16x8, w); }
__device__ __forceinline__ f32x2v bf2(unsigned w) { return (f32x2v){bflo(w), bfhi(w)}; }
__device__ __forceinline__ void scan_P(LAS unsigned char* L, const unsigned (&q2)[8], const unsigned (&g2)[8], const unsigned (&v2)[8], int cp, int rgp, int l15) {
    constexpr float LOG2E = 1.4426950408889634f;
    f32x2v G[8], f[8]; f32x2v s = {0.f, 0.f};
#pragma unroll
    for (int i = 0; i < 8; ++i) { G[i] = bf2(g2[i]) * LOG2E; s += G[i]; f[i].x = ex2(G[i].x); f[i].y = ex2(G[i].y); }
    const float Ta0 = __shfl(s.x, l15), Ta1 = __shfl(s.x, l15 + 16), Ta2 = __shfl(s.x, l15 + 32), Ta3 = __shfl(s.x, l15 + 48);
    const float Tb0 = __shfl(s.y, l15), Tb1 = __shfl(s.y, l15 + 16), Tb2 = __shfl(s.y, l15 + 32), Tb3 = __shfl(s.y, l15 + 48);
    const f32x2v c15 = {Ta0 + Ta1, Tb0 + Tb1}, c31 = {c15.x + Ta2 + Ta3, c15.y + Tb2 + Tb3};
    f32x2v r0 = {(rgp > 0 ? Ta0 : 0.f) + (rgp > 1 ? Ta1 : 0.f) + (rgp > 2 ? Ta2 : 0.f), (rgp > 0 ? Tb0 : 0.f) + (rgp > 1 ? Tb1 : 0.f) + (rgp > 2 ? Tb2 : 0.f)};
    r0 -= c15;
    f32x2v e = {ex2(fminf(fmaxf(r0.x, -100.f), 100.f)), ex2(fminf(fmaxf(r0.y, -100.f), 100.f))};
    const f32x2v E15 = {ex2(c15.x), ex2(c15.y)}, Dd = {ex2(c31.x - c15.x), ex2(c31.y - c15.y)};
    unsigned kta[4], ktb[4], vta[4], vtb[4];
#pragma unroll
    for (int j = 0; j < 4; ++j) { f32x2v ke[2];
#pragma unroll
        for (int t = 0; t < 2; ++t) { const int i = 2 * j + t; const int row = 8 * rgp + i;
            e = e * f[i]; e.x = fmaxf(e.x, 1e-30f); e.y = fmaxf(e.y, 1e-30f);
            const f32x2v ek = {__builtin_amdgcn_rcpf(e.x), __builtin_amdgcn_rcpf(e.y)};
            const f32x2v qm = bf2(q2[i]) * e, km = (1.0f - f[i]) * ek, qe = qm * E15;
            const int off = row * 256 + ((4 * cp) ^ ((row & 15) << 4));
            *(LAS unsigned*)(L + SC_QM + off) = pg8::cvt_pk_bf16(qm.x, qm.y);
            *(LAS unsigned*)(L + SC_KM + off) = pg8::cvt_pk_bf16(km.x, km.y);
            *(LAS unsigned*)(L + SC_QE + off) = pg8::cvt_pk_bf16(qe.x, qe.y);
            ke[t] = km * Dd; }
        kta[j] = pg8::cvt_pk_bf16(ke[0].x, ke[1].x); ktb[j] = pg8::cvt_pk_bf16(ke[0].y, ke[1].y);
        vta[j] = (v2[2 * j] & 0xffffu) | (v2[2 * j + 1] << 16); vtb[j] = (v2[2 * j] >> 16) | (v2[2 * j + 1] & 0xffff0000u); }
    *(LAS v4u*)(L + SC_KT + (2 * cp) * SC_RS + 16 * rgp) = (v4u){kta[0], kta[1], kta[2], kta[3]};
    *(LAS v4u*)(L + SC_KT + (2 * cp + 1) * SC_RS + 16 * rgp) = (v4u){ktb[0], ktb[1], ktb[2], ktb[3]};
    *(LAS v4u*)(L + SC_VT + (2 * cp) * SC_RS + 16 * rgp) = (v4u){vta[0], vta[1], vta[2], vta[3]};
    *(LAS v4u*)(L + SC_VT + (2 * cp + 1) * SC_RS + 16 * rgp) = (v4u){vtb[0], vtb[1], vtb[2], vtb[3]};
    if (rgp == 0) *(LAS f32x2v*)(L + SC_EL + 8 * cp) = (f32x2v){ex2(c31.x), ex2(c31.y)};
}
__device__ __forceinline__ void scan_M(const LAS unsigned char* L, LAS unsigned char* ot_lds, f32x16 (&S)[4], int w, int n, int h, bf16* op, long ostep) {
    f32x16 X;
#pragma unroll
    for (int r = 0; r < 16; ++r) X[r] = 0.f;
#pragma unroll
    for (int ks = 0; ks < 8; ++ks) { const int off = n * 256 + ((32 * ks + 16 * h) ^ ((n & 15) << 4));
        const bf16x8 a = *(const LAS bf16x8*)(L + SC_KM + off), b = *(const LAS bf16x8*)(L + SC_QM + off);
        X = __builtin_amdgcn_mfma_f32_32x32x16_bf16(a, b, X, 0, 0, 0); }
#pragma unroll
    for (int r = 0; r < 16; ++r) { const int s = (r & 3) + 8 * (r >> 2) + 4 * h; X[r] = (s <= n) ? X[r] : 0.f; }
    f32x16 o;
#pragma unroll
    for (int r = 0; r < 16; ++r) o[r] = 0.f;
    const int vrow = (32 * w + n) * SC_RS;
#pragma unroll
    for (int st = 0; st < 2; ++st) {
        const bf16x8 xa = mk8(pg8::cvt_pk_bf16(X[8 * st + 0], X[8 * st + 1]), pg8::cvt_pk_bf16(X[8 * st + 2], X[8 * st + 3]), pg8::cvt_pk_bf16(X[8 * st + 4], X[8 * st + 5]), pg8::cvt_pk_bf16(X[8 * st + 6], X[8 * st + 7]));
        const u64 lo = *(const LAS u64*)(L + SC_VT + vrow + 32 * st + 8 * h), hi = *(const LAS u64*)(L + SC_VT + vrow + 32 * st + 8 * h + 16);
        o = __builtin_amdgcn_mfma_f32_32x32x16_bf16(xa, mk8q(lo, hi), o, 0, 0, 0); }
#pragma unroll
    for (int i = 0; i < 4; ++i)
#pragma unroll
        for (int st = 0; st < 2; ++st) { const int cb0 = 64 * i + 32 * st + 8 * h, sw = (n & 15) << 4;
            const u64 lo = *(const LAS u64*)(L + SC_QE + n * 256 + (cb0 ^ sw)), hi = *(const LAS u64*)(L + SC_QE + n * 256 + ((cb0 + 16) ^ sw));
            const bf16x8 sb = mk8(pg8::cvt_pk_bf16(S[i][8 * st + 0], S[i][8 * st + 1]), pg8::cvt_pk_bf16(S[i][8 * st + 2], S[i][8 * st + 3]), pg8::cvt_pk_bf16(S[i][8 * st + 4], S[i][8 * st + 5]), pg8::cvt_pk_bf16(S[i][8 * st + 6], S[i][8 * st + 7]));
            o = __builtin_amdgcn_mfma_f32_32x32x16_bf16(mk8q(lo, hi), sb, o, 0, 0, 0); }
#pragma unroll
    for (int i = 0; i < 4; ++i) {
#pragma unroll
        for (int q = 0; q < 4; ++q) { const f32x4 el = *(const LAS f32x4*)(L + SC_EL + 4 * (32 * i + 8 * q + 4 * h));
#pragma unroll
            for (int j = 0; j < 4; ++j) S[i][4 * q + j] *= el[j]; }
#pragma unroll
        for (int st = 0; st < 2; ++st) { const bf16x8 a = *(const LAS bf16x8*)(L + SC_KT + (32 * i + n) * SC_RS + 32 * st + 16 * h), b = *(const LAS bf16x8*)(L + SC_VT + vrow + 32 * st + 16 * h);
            S[i] = __builtin_amdgcn_mfma_f32_32x32x16_bf16(a, b, S[i], 0, 0, 0); } }
    LAS float* ot = (LAS float*)(ot_lds);
#pragma unroll
    for (int r = 0; r < 16; ++r) ot[((r & 3) + 8 * (r >> 2) + 4 * h) * 33 + n] = o[r];
    asm volatile("s_waitcnt lgkmcnt(0)" ::: "memory");
    { const int lane = 32 * h + n, row = lane >> 1, c0 = (lane & 1) * 16; const LAS float* src = ot + row * 33 + c0;
      v4u w0, w1;
      w0.x = pg8::cvt_pk_bf16(src[0], src[1]); w0.y = pg8::cvt_pk_bf16(src[2], src[3]); w0.z = pg8::cvt_pk_bf16(src[4], src[5]); w0.w = pg8::cvt_pk_bf16(src[6], src[7]);
      w1.x = pg8::cvt_pk_bf16(src[8], src[9]); w1.y = pg8::cvt_pk_bf16(src[10], src[11]); w1.z = pg8::cvt_pk_bf16(src[12], src[13]); w1.w = pg8::cvt_pk_bf16(src[14], src[15]);
      bf16* dst = op + (long)row * ostep + c0; *(GAS v4u*)dst = w0; *(GAS v4u*)(dst + 8) = w1; }
    asm volatile("s_waitcnt lgkmcnt(0)" ::: "memory");
}
__device__ __forceinline__ void scan_opt(const Frame& F, const bf16* PROJ, bf16* OPART, int u) {
    constexpr int NCH = SEQ / 32;
    const int dir = u / 48, sl = (u % 48) / NHEAD, head = u % NHEAD;
    const int lane = F.lane, W = F.wave, w = W & 3;
    LAS unsigned char* L0 = F.lds + RING_OFF;
    if (W >= 4) {
        const int cp = 16 * w + (lane & 15), rgp = lane >> 4, l15 = lane & 15;
        const GAS char* bq = (const GAS char*)(PROJ + (size_t)(sl * SEQ) * P_A + head * HD);
        const GAS char* bg = bq + (size_t)(TOKW + dir * TOKW) * 2; const GAS char* bv = bq + (size_t)(3 * TOKW) * 2;
        const int rstep = dir ? -(P_A * 2) : (P_A * 2);
        unsigned voff = (unsigned)((dir ? (SEQ - 1 - 8 * rgp) : (8 * rgp)) * (P_A * 2) + 4 * cp);
        const int cstep = 32 * rstep;
        unsigned qA[8], gA[8], vA[8], qB[8], gB[8], vB[8], qC[8], gC[8], vC[8];
#define SC_LOAD(Q_, G_, V_) do { _Pragma("unroll") for (int i = 0; i < 8; ++i) { const unsigned o_ = voff + (unsigned)(i * rstep); \
        Q_[i] = *(const GAS unsigned*)(bq + o_); G_[i] = *(const GAS unsigned*)(bg + o_); V_[i] = *(const GAS unsigned*)(bv + o_); } voff += (unsigned)cstep; } while (0)
#define SC_STEP(c_, QL, GL, VL, QP, GP, VP, BUF_) do { if ((c_) + 3 < NCH) SC_LOAD(QL, GL, VL); if ((c_) + 1 < NCH) scan_P(L0 + (BUF_) * SC_DIR, QP, GP, VP, cp, rgp, l15); __syncthreads(); } while (0)
        SC_LOAD(qA, gA, vA); SC_LOAD(qB, gB, vB); SC_LOAD(qC, gC, vC);
        scan_P(L0, qA, gA, vA, cp, rgp, l15);
        __syncthreads();
        int c = 0;
        for (; c + 6 <= NCH; c += 6) {
            SC_STEP(c + 0, qA, gA, vA, qB, gB, vB, 1);
            SC_STEP(c + 1, qB, gB, vB, qC, gC, vC, 0);
            SC_STEP(c + 2, qC, gC, vC, qA, gA, vA, 1);
            SC_STEP(c + 3, qA, gA, vA, qB, gB, vB, 0);
            SC_STEP(c + 4, qB, gB, vB, qC, gC, vC, 1);
            SC_STEP(c + 5, qC, gC, vC, qA, gA, vA, 0);
        }
        SC_STEP(c + 0, qA, gA, vA, qB, gB, vB, 1);
        SC_STEP(c + 1, qB, gB, vB, qC, gC, vC, 0);
        static_assert(NCH % 6 == 2, "tail of the producer loop is written for NCH = 6k + 2");
#undef SC_STEP
#undef SC_LOAD
    } else {
        const int n = lane & 31, h = lane >> 5;
        f32x16 S[4];
#pragma unroll
        for (int i = 0; i < 4; ++i)
#pragma unroll
            for (int r = 0; r < 16; ++r) S[i][r] = 0.f;
        const long ostep = dir ? -(long)TOKW : (long)TOKW;
        bf16* op = OPART + ((size_t)dir * GT + sl * SEQ + (dir ? SEQ - 1 : 0)) * TOKW + head * HD + 32 * w;
        LAS unsigned char* otl = L0 + 2 * SC_DIR + w * 4352;
        __syncthreads();
        for (int c = 0; c < NCH; c += 2) {
            scan_M(L0, otl, S, w, n, h, op, ostep); op += 32 * ostep;
            __syncthreads();
            scan_M(L0 + SC_DIR, otl, S, w, n, h, op, ostep); op += 32 * ostep;
            __syncthreads();
        }
    }
}
__device__ __forceinline__ void combine_naive(const Frame& F0, int a, int item) {
    Frame F = F0; F.lane = lane_id_fresh(); F.tid = F.wave * 64 + F.lane;
    const bf16* PROJ = FWS(bf16, WS_PROJ); const bf16* OPART = FWS(bf16, WS_OPART); bf16* OG = OGBUF(item); const float* onorm_g = FIN(11) + a * TOKW;
    const int gw = blockIdx.x * NWAVES + F.wave, NGW = F.G * NWAVES, lane = F.lane;
    f32x4 gv[12];
    { const GAS f32x4* gn = (const GAS f32x4*)onorm_g + lane;
#pragma unroll
      for (int hp = 0; hp < 12; ++hp) gv[hp] = gn[64 * hp]; }
    for (int tau = gw; tau < GT; tau += NGW) {
        const GAS u64* p0 = (const GAS u64*)(OPART + (size_t)tau * TOKW) + lane; const GAS u64* p1 = (const GAS u64*)(OPART + ((size_t)GT + tau) * TOKW) + lane;
        const GAS u64* sg = (const GAS u64*)(PROJ + (size_t)tau * P_A + GATE_A) + lane;
        GAS u64* og = (GAS u64*)(OG + (size_t)tau * MIXW) + lane;
        u64 a0[12], a1[12], sv[12];
#pragma unroll
        for (int hp = 0; hp < 12; ++hp) { a0[hp] = p0[64 * hp]; a1[hp] = p1[64 * hp]; sv[hp] = sg[64 * hp]; }
#pragma unroll
        for (int hp = 0; hp < 12; ++hp) {
            const f32x4 o = {bflo((unsigned)a0[hp]) + bflo((unsigned)a1[hp]), bfhi((unsigned)a0[hp]) + bfhi((unsigned)a1[hp]), bflo((unsigned)(a0[hp] >> 32)) + bflo((unsigned)(a1[hp] >> 32)), bfhi((unsigned)(a0[hp] >> 32)) + bfhi((unsigned)(a1[hp] >> 32))};
            float ss = (o.x * o.x + o.y * o.y) + (o.z * o.z + o.w * o.w);
#pragma unroll
            for (int m = 1; m < 32; m <<= 1) ss += __shfl_xor(ss, m);
            const float rs = rsqrtf(ss * (1.0f / HD) + EPS); const u64 s = sv[hp];
            const unsigned lo = pg8::cvt_pk_bf16(o.x * rs * gv[hp].x * bflo((unsigned)s), o.y * rs * gv[hp].y * bfhi((unsigned)s));
            const unsigned hi = pg8::cvt_pk_bf16(o.z * rs * gv[hp].z * bflo((unsigned)(s >> 32)), o.w * rs * gv[hp].w * bfhi((unsigned)(s >> 32)));
            og[64 * hp] = (u64)lo | ((u64)hi << 32); }
    }
}
__device__ __forceinline__ void na_naive_item(Frame& F, const bf16* PROJ, bf16* OG, const float* rpb, int bi, int tau, int head) {
    const int lane = F.lane; LAS float* qsh = (LAS float*)(F.lds + RING_OFF) + F.wave * 512; LAS float* psh = qsh + 256;
    const int sl = tau >> 12, t = tau & 4095, r = t >> 6, c = t & 63;
    const int rs = min(max(r - 4, 0), 56), cs = min(max(c - 8, 0), 48);
    { const unsigned w = *(const GAS unsigned*)(PROJ + (size_t)tau * P_B + head * HD + 2 * lane); qsh[2 * lane] = bflo(w); qsh[2 * lane + 1] = bfhi(w); }
    LDS_WAIT(); asm volatile("" ::: "memory");
    float s[2];
#pragma unroll
    for (int jj = 0; jj < 2; ++jj) { const int n = lane + 64 * jj, j = n >> 4, i = n & 15; const int ktok = sl * SEQ + (rs + j) * 64 + cs + i;
        const bf16* krow = PROJ + (size_t)ktok * P_B + TOKW + head * HD; float dot = 0.f;
        for (int d8 = 0; d8 < 16; ++d8) { const bf16x8 k8 = *(const GAS bf16x8*)(krow + d8 * 8); const f32x4 qa = *(const LAS f32x4*)(qsh + d8 * 8), qb = *(const LAS f32x4*)(qsh + d8 * 8 + 4);
#pragma unroll
            for (int e = 0; e < 4; ++e) { dot += qa[e] * bf2f((unsigned short)k8[e]); dot += qb[e] * bf2f((unsigned short)k8[4 + e]); } }
        s[jj] = dot + rpb[((size_t)(bi * NHEAD + head) * 15 + (rs + j - r + 7)) * 31 + (cs + i - c + 15)]; }
    const float m = wave_max(fmaxf(s[0], s[1])); const float e0 = __expf(s[0] - m), e1 = __expf(s[1] - m); const float inv = 1.0f / wave_sum(e0 + e1);
    psh[lane] = e0 * inv; psh[lane + 64] = e1 * inv;
    LDS_WAIT(); asm volatile("" ::: "memory");
    float a0 = 0.f, a1 = 0.f;
    for (int n = 0; n < 128; ++n) { const int j = n >> 4, i = n & 15; const int ktok = sl * SEQ + (rs + j) * 64 + cs + i;
        const unsigned w = *(const GAS unsigned*)(PROJ + (size_t)ktok * P_B + 2 * TOKW + head * HD + 2 * lane); const float p = psh[n]; a0 += p * bflo(w); a1 += p * bfhi(w); }
    const unsigned sg = *(const GAS unsigned*)(PROJ + (size_t)tau * P_B + GATE_B + head * HD + 2 * lane);
    *(GAS unsigned*)(OG + (size_t)tau * MIXW + head * HD + 2 * lane) = pg8::cvt_pk_bf16(a0 * bflo(sg), a1 * bfhi(sg));
    LDS_WAIT(); asm volatile("" ::: "memory");
}
__device__ __forceinline__ void mem_naive_item(Frame& F, const bf16* PROJ, bf16* OG, const bf16* KV, int layer, int g, int tau, int mh) {
    const int lane = F.lane; LAS float* qsh = (LAS float*)(F.lds + RING_OFF) + F.wave * 512; LAS float* psh = qsh + 256;
    const int P = (layer & 1) ? P_B : P_A, QM = (layer & 1) ? QM_B : QM_A, GATE = (layer & 1) ? GATE_B : GATE_A;
    const int seq = g * 2 + (tau >> 12);
    const bf16* kv = KV + ((size_t)layer * 2560 + seq * NMEM) * 2048;
    { const unsigned long long w = *(const GAS unsigned long long*)(PROJ + (size_t)tau * P + QM + mh * MHD + 4 * lane);
      qsh[4 * lane] = bflo((unsigned)w); qsh[4 * lane + 1] = bfhi((unsigned)w); qsh[4 * lane + 2] = bflo((unsigned)(w >> 32)); qsh[4 * lane + 3] = bfhi((unsigned)(w >> 32)); }
    LDS_WAIT(); asm volatile("" ::: "memory");
    float s[4];
#pragma unroll
    for (int jj = 0; jj < 4; ++jj) { const int m = lane + 64 * jj; const bf16* krow = kv + (size_t)m * 2048 + mh * MHD; float dot = 0.f;
        for (int d8 = 0; d8 < 32; ++d8) { const bf16x8 k8 = *(const GAS bf16x8*)(krow + d8 * 8); const f32x4 qa = *(const LAS f32x4*)(qsh + d8 * 8), qb = *(const LAS f32x4*)(qsh + d8 * 8 + 4);
#pragma unroll
            for (int e = 0; e < 4; ++e) { dot += qa[e] * bf2f((unsigned short)k8[e]); dot += qb[e] * bf2f((unsigned short)k8[4 + e]); } }
        s[jj] = dot; }
    const float mx = wave_max(fmaxf(fmaxf(s[0], s[1]), fmaxf(s[2], s[3])));
    float e[4]; float es = 0.f;
#pragma unroll
    for (int jj = 0; jj < 4; ++jj) { e[jj] = __expf(s[jj] - mx); es += e[jj]; }
    const float inv = 1.0f / wave_sum(es);
#pragma unroll
    for (int jj = 0; jj < 4; ++jj) psh[lane + 64 * jj] = e[jj] * inv;
    LDS_WAIT(); asm volatile("" ::: "memory");
    float a0 = 0.f, a1 = 0.f, a2 = 0.f, a3 = 0.f;
    for (int m = 0; m < NMEM; ++m) { const unsigned long long w = *(const GAS unsigned long long*)(kv + (size_t)m * 2048 + MEMW + mh * MHD + 4 * lane); const float p = psh[m];
        a0 += p * bflo((unsigned)w); a1 += p * bfhi((unsigned)w); a2 += p * bflo((unsigned)(w >> 32)); a3 += p * bfhi((unsigned)(w >> 32)); }
    const unsigned long long sg = *(const GAS unsigned long long*)(PROJ + (size_t)tau * P + GATE + TOKW + mh * MHD + 4 * lane);
    const unsigned lo = pg8::cvt_pk_bf16(a0 * bflo((unsigned)sg), a1 * bfhi((unsigned)sg)), hi = pg8::cvt_pk_bf16(a2 * bflo((unsigned)(sg >> 32)), a3 * bfhi((unsigned)(sg >> 32)));
    *(GAS unsigned long long*)(OG + (size_t)tau * MIXW + TOKW + mh * MHD + 4 * lane) = (unsigned long long)lo | ((unsigned long long)hi << 32);
    LDS_WAIT(); asm volatile("" ::: "memory");
}
typedef short s16x4 __attribute__((ext_vector_type(4)));
constexpr int AT_K = 0, AT_V = 32768, AT_B = 49152;
__device__ __forceinline__ int v_st_plain(int k, int c) { return ((k >> 3) * 4 + (c >> 5)) * 512 + ((k & 7) * 32 + (c & 31)) * 2; }
__device__ __forceinline__ int v_rd_base(int lane) { return ((lane & 3) << 3) | (((lane >> 2) & 3) << 6) | (((lane >> 4) & 1) << 5) | (((lane >> 5) & 1) << 8); }
constexpr int v_rd_off(int d0, int ks, int half) { return d0 * 512 + ks * 4096 + half * 2048; }
template <int OFF> __device__ __forceinline__ s16x4 tr_read(int vb) { s16x4 r; asm volatile("ds_read_b64_tr_b16 %0, %1 offset:%2" : "=&v"(r) : "v"(vb), "i"(OFF) : "memory"); return r; }
template <int D0> __device__ __forceinline__ void pv_one(f32x16& od, int vb, bf16x8 b0, bf16x8 b1, bf16x8 b2, bf16x8 b3) {
    const s16x4 l0 = tr_read<v_rd_off(D0, 0, 0)>(vb), h0 = tr_read<v_rd_off(D0, 0, 1)>(vb), l1 = tr_read<v_rd_off(D0, 1, 0)>(vb), h1 = tr_read<v_rd_off(D0, 1, 1)>(vb);
    const s16x4 l2 = tr_read<v_rd_off(D0, 2, 0)>(vb), h2 = tr_read<v_rd_off(D0, 2, 1)>(vb), l3 = tr_read<v_rd_off(D0, 3, 0)>(vb), h3 = tr_read<v_rd_off(D0, 3, 1)>(vb);
    asm volatile("s_waitcnt lgkmcnt(0)" ::: "memory"); __builtin_amdgcn_sched_barrier(0);
#define AT_PK(L_, H_) (bf16x8){L_[0], L_[1], L_[2], L_[3], H_[0], H_[1], H_[2], H_[3]}
    od = __builtin_amdgcn_mfma_f32_32x32x16_bf16(AT_PK(l0, h0), b0, od, 0, 0, 0);
    od = __builtin_amdgcn_mfma_f32_32x32x16_bf16(AT_PK(l1, h1), b1, od, 0, 0, 0);
    od = __builtin_amdgcn_mfma_f32_32x32x16_bf16(AT_PK(l2, h2), b2, od, 0, 0, 0);
    od = __builtin_amdgcn_mfma_f32_32x32x16_bf16(AT_PK(l3, h3), b3, od, 0, 0, 0);
#undef AT_PK
}
template <int NQK, bool NA>
__device__ __forceinline__ void attn_item(const Frame& F, const bf16* qp, const bf16* kv, int rstride, int kcol, int vcol, int tlo, int thi, int alo, int ahi, int qcol, int cs, int rq, bf16* og, const bf16* sg) {
    constexpr int ROWB = NQK * 32, KP = NQK / 4; constexpr float LOG2E = 1.4426950408889634f;
    const int tid = F.tid, lane = F.lane, n = lane & 31, h = lane >> 5;
    LAS unsigned char* Kl = F.lds + RING_OFF + AT_K; LAS unsigned char* Vl = F.lds + RING_OFF + AT_V; const LAS float* Bl = (const LAS float*)(F.lds + RING_OFF + AT_B);
    constexpr bool QREG = (NQK <= 8);
    bf16x8 qr[QREG ? NQK : 1];
    if (QREG) {
#pragma unroll
        for (int d0 = 0; d0 < NQK; ++d0) qr[d0] = *(const GAS bf16x8*)(qp + 16 * d0); }
    f32x16 o[4];
#pragma unroll
    for (int d = 0; d < 4; ++d)
#pragma unroll
        for (int r = 0; r < 16; ++r) o[d][r] = 0.f;
    float m = -1e30f, l = 0.f;
    bf16x8 ks_[KP], vs_[2];
    int krow[KP], kch[KP];
#pragma unroll
    for (int i = 0; i < KP; ++i) { const int p = tid + 512 * i; krow[i] = p / (NQK * 2); kch[i] = p % (NQK * 2); }
    const int vrow0 = tid >> 4, vc = (tid & 15) * 8;
#define AT_LOAD(t_) do { const bf16* b_ = kv + (size_t)(t_) * 64 * rstride; \
        _Pragma("unroll") for (int i = 0; i < KP; ++i) ks_[i] = *(const GAS bf16x8*)(b_ + (size_t)krow[i] * rstride + kcol + kch[i] * 8); \
        _Pragma("unroll") for (int i = 0; i < 2; ++i) vs_[i] = *(const GAS bf16x8*)(b_ + (size_t)(vrow0 + 32 * i) * rstride + vcol + vc); } while (0)
#define AT_WRITE() do { _Pragma("unroll") for (int i = 0; i < KP; ++i) *(LAS bf16x8*)(Kl + krow[i] * ROWB + ((kch[i] * 16) ^ ((krow[i] & 7) << 4))) = ks_[i]; \
        _Pragma("unroll") for (int i = 0; i < 2; ++i) *(LAS bf16x8*)(Vl + v_st_plain(vrow0 + 32 * i, vc)) = vs_[i]; } while (0)
    const int vb = (int)(size_t)Vl + v_rd_base(lane);
    AT_LOAD(tlo);
    for (int t = tlo; t <= thi; ++t) {
        __syncthreads();
        AT_WRITE();
        if (t < thi) AT_LOAD(t + 1);
        __syncthreads();
        if (t >= alo && t <= ahi) {
            f32x16 p0, p1;
#pragma unroll
            for (int r = 0; r < 16; ++r) { p0[r] = 0.f; p1[r] = 0.f; }
            if (QREG) {
#pragma unroll
                for (int d0 = 0; d0 < NQK; ++d0) { const int cb = (32 * d0 + 16 * h) ^ ((n & 7) << 4);
                    const bf16x8 a0 = *(const LAS bf16x8*)(Kl + n * ROWB + cb), a1 = *(const LAS bf16x8*)(Kl + (32 + n) * ROWB + cb);
                    p0 = __builtin_amdgcn_mfma_f32_32x32x16_bf16(a0, qr[QREG ? d0 : 0], p0, 0, 0, 0);
                    p1 = __builtin_amdgcn_mfma_f32_32x32x16_bf16(a1, qr[QREG ? d0 : 0], p1, 0, 0, 0); }
            } else {
#pragma unroll
                for (int dq = 0; dq < NQK; dq += 4) { bf16x8 qq[4];
#pragma unroll
                    for (int e = 0; e < 4; ++e) qq[e] = *(const GAS bf16x8*)(qp + 16 * (dq + e));
#pragma unroll
                    for (int e = 0; e < 4; ++e) { const int cb = (32 * (dq + e) + 16 * h) ^ ((n & 7) << 4);
                        const bf16x8 a0 = *(const LAS bf16x8*)(Kl + n * ROWB + cb), a1 = *(const LAS bf16x8*)(Kl + (32 + n) * ROWB + cb);
                        p0 = __builtin_amdgcn_mfma_f32_32x32x16_bf16(a0, qq[e], p0, 0, 0, 0);
                        p1 = __builtin_amdgcn_mfma_f32_32x32x16_bf16(a1, qq[e], p1, 0, 0, 0); }
                    asm volatile("" ::: "memory"); }
            }
            if (NA) { const int dr = t - rq + 7; const LAS float* brow = Bl + dr * 32 + (15 - qcol);
#pragma unroll
                for (int r = 0; r < 16; ++r) { const int kc0 = (r & 3) + 8 * (r >> 2) + 4 * h, kc1 = kc0 + 32;
                    const float b0 = brow[kc0], b1 = brow[kc1];
                    p0[r] = (kc0 >= cs && kc0 < cs + 16) ? (p0[r] + b0) * LOG2E : -1e30f;
                    p1[r] = (kc1 >= cs && kc1 < cs + 16) ? (p1[r] + b1) * LOG2E : -1e30f; }
            } else {
#pragma unroll
                for (int r = 0; r < 16; ++r) { p0[r] *= LOG2E; p1[r] *= LOG2E; }
            }
            float pm = p0[0];
#pragma unroll
            for (int r = 1; r < 16; ++r) pm = fmaxf(pm, p0[r]);
#pragma unroll
            for (int r = 0; r < 16; ++r) pm = fmaxf(pm, p1[r]);
            pm = fmaxf(pm, __shfl_xor(pm, 32));
            const float mn = fmaxf(m, pm), alpha = ex2(m - mn); m = mn;
            float ps = 0.f;
#pragma unroll
            for (int r = 0; r < 16; ++r) { p0[r] = ex2(p0[r] - mn); p1[r] = ex2(p1[r] - mn); ps += p0[r] + p1[r]; }
            l = l * alpha + ps;
            if (__any(alpha < 1.0f)) {
#pragma unroll
                for (int d = 0; d < 4; ++d)
#pragma unroll
                    for (int r = 0; r < 16; ++r) o[d][r] *= alpha; }
            const bf16x8 b0 = mk8(pg8::cvt_pk_bf16(p0[0], p0[1]), pg8::cvt_pk_bf16(p0[2], p0[3]), pg8::cvt_pk_bf16(p0[4], p0[5]), pg8::cvt_pk_bf16(p0[6], p0[7]));
            const bf16x8 b1 = mk8(pg8::cvt_pk_bf16(p0[8], p0[9]), pg8::cvt_pk_bf16(p0[10], p0[11]), pg8::cvt_pk_bf16(p0[12], p0[13]), pg8::cvt_pk_bf16(p0[14], p0[15]));
            const bf16x8 b2 = mk8(pg8::cvt_pk_bf16(p1[0], p1[1]), pg8::cvt_pk_bf16(p1[2], p1[3]), pg8::cvt_pk_bf16(p1[4], p1[5]), pg8::cvt_pk_bf16(p1[6], p1[7]));
            const bf16x8 b3 = mk8(pg8::cvt_pk_bf16(p1[8], p1[9]), pg8::cvt_pk_bf16(p1[10], p1[11]), pg8::cvt_pk_bf16(p1[12], p1[13]), pg8::cvt_pk_bf16(p1[14], p1[15]));
            pv_one<0>(o[0], vb, b0, b1, b2, b3); pv_one<1>(o[1], vb, b0, b1, b2, b3); pv_one<2>(o[2], vb, b0, b1, b2, b3); pv_one<3>(o[3], vb, b0, b1, b2, b3);
        }
    }
#undef AT_LOAD
#undef AT_WRITE
    const float linv = 1.0f / (l + __shfl_xor(l, 32));
#pragma unroll
    for (int d = 0; d < 4; ++d)
#pragma unroll
        for (int q4 = 0; q4 < 4; ++q4) { const int vcol0 = 32 * d + 8 * q4 + 4 * h;
            const u64 g = *(const GAS u64*)(sg + vcol0);
            const unsigned lo = pg8::cvt_pk_bf16(o[d][4 * q4 + 0] * linv * bflo((unsigned)g), o[d][4 * q4 + 1] * linv * bfhi((unsigned)g));
            const unsigned hi = pg8::cvt_pk_bf16(o[d][4 * q4 + 2] * linv * bflo((unsigned)(g >> 32)), o[d][4 * q4 + 3] * linv * bfhi((unsigned)(g >> 32)));
            *(GAS u64*)(og + vcol0) = (u64)lo | ((u64)hi << 32); }
}
__device__ __forceinline__ void na_item(const Frame& F, const bf16* PROJ, bf16* OG, const float* rpb, int bi, int sl, int head, int rb) {
    const int W = F.wave, lane = F.lane, n = lane & 31, h = lane >> 5;
    __syncthreads();
    { LAS float* Bl = (LAS float*)(F.lds + RING_OFF + AT_B); const int dr = F.tid >> 5, dc = F.tid & 31;
      if (dr < 15) Bl[dr * 32 + dc] = dc < 31 ? rpb[((size_t)(bi * NHEAD + head) * 15 + dr) * 31 + dc] : 0.f; }
    const int r0 = 4 * rb, rq = r0 + (W >> 1), qcol = 32 * (W & 1) + n;
    const int tlo = min(max(r0 - 4, 0), 56), thi = min(max(r0 + 3 - 4, 0), 56) + 7, alo = min(max(rq - 4, 0), 56), ahi = alo + 7;
    const int cs = min(max(qcol - 8, 0), 48);
    const size_t tok = (size_t)sl * SEQ + rq * 64 + qcol;
    attn_item<8, true>(F, PROJ + tok * P_B + head * HD + 8 * h, PROJ + (size_t)sl * SEQ * P_B, P_B, TOKW + head * HD, 2 * TOKW + head * HD, tlo, thi, alo, ahi, qcol, cs, rq,
                       OG + tok * MIXW + head * HD, PROJ + tok * P_B + GATE_B + head * HD);
}
typedef float f32x4a __attribute__((ext_vector_type(4)));
constexpr int NA2_TILE = 32768, NA2_BUF = 65536, NA2_V = 16384, NA2_BIAS = 131072 + 1024;
__device__ __forceinline__ s16x4 tr_read_rt(int addr, int) { s16x4 r; asm volatile("ds_read_b64_tr_b16 %0, %1" : "=&v"(r) : "v"(addr) : "memory"); return r; }
template <int OFF> __device__ __forceinline__ s16x4 tr_read_o(int vb) { s16x4 r; asm volatile("ds_read_b64_tr_b16 %0, %1 offset:%2" : "=&v"(r) : "v"(vb), "i"(OFF) : "memory"); return r; }
__device__ __forceinline__ void na_item2(const Frame& F, const bf16* PROJ, const bf16* QH, bf16* OG, const float* rpb, int bi, int sl, int head, int rb) {
    constexpr float LOG2E = 1.4426950408889634f;
    const int W = F.wave, lane = F.lane, tid = F.tid, ql = lane & 15, g = lane >> 4;
    LAS unsigned char* L = F.lds + RING_OFF;
    __syncthreads();
    { LAS float* Bl = (LAS float*)(L + NA2_BIAS); const int dr = tid >> 5, dc = tid & 31;
      if (dr < 15) Bl[dr * 32 + dc] = dc < 31 ? rpb[((size_t)(bi * NHEAD + head) * 15 + dr) * 31 + dc] * LOG2E : 0.f; }
    const int r0 = 4 * rb, rq = r0 + (W >> 1), hq = W & 1;
    const int tlo = min(max(r0 - 4, 0), 56), thi = min(max(r0 + 3 - 4, 0), 56) + 7, alo = min(max(rq - 4, 0), 56), ahi = alo + 7;
    bf16x8 qf[2][4]; unsigned vmask[2]; int bidx[2][2], koff[2][2][4], vbase[2][2];
    const bf16* ogp[2]; const bf16* sgp[2];
#pragma unroll
    for (int bq = 0; bq < 2; ++bq) { const int b = 2 * hq + bq, kst = (b == 0) ? 0 : (b == 1) ? 8 : (b == 2) ? 24 : 32, qc = 16 * b + ql, cs = min(max(qc - 8, 0), 48);
        const size_t tok = (size_t)sl * SEQ + rq * 64 + qc;
#pragma unroll
        for (int s = 0; s < 4; ++s) qf[bq][s] = *(const GAS bf16x8*)(QH + ((size_t)head * GT + tok) * HD + 32 * s + 8 * g);
        ogp[bq] = OG + tok * MIXW + head * HD + 4 * g; sgp[bq] = PROJ + tok * P_B + GATE_B + head * HD + 4 * g;
        unsigned vm = 0;
#pragma unroll
        for (int blk = 0; blk < 2; ++blk) { const int kc0 = kst + 16 * blk + 4 * g;
#pragma unroll
            for (int r = 0; r < 4; ++r) vm |= ((kc0 + r >= cs && kc0 + r < cs + 16) ? 1u : 0u) << (4 * blk + r);
            bidx[bq][blk] = NA2_BIAS + 4 * (kc0 - qc + 15);
            const int krow = kst + 16 * blk + ql;
#pragma unroll
            for (int s = 0; s < 4; ++s) koff[bq][blk][s] = krow * 256 + (((4 * s + g) * 16) ^ ((krow & 7) << 4));
            const int kt = (kst >> 3) + 2 * blk + (g >> 1);
            vbase[bq][blk] = NA2_V + kt * 2048 + ((4 * g + (ql >> 2)) & 7) * 32 + 8 * (ql & 3); }
        vmask[bq] = vm; }
    f32x4a o[2][8];
#pragma unroll
    for (int bq = 0; bq < 2; ++bq)
#pragma unroll
        for (int vt = 0; vt < 8; ++vt) o[bq][vt] = (f32x4a){0.f, 0.f, 0.f, 0.f};
    float m[2] = {-1e30f, -1e30f}, l[2] = {0.f, 0.f};
    const int sr = tid >> 4, sc = (tid & 15) * 8;
    const bf16* kvb = QH + ((size_t)(NHEAD + head) * GT + (size_t)sl * SEQ + sr) * HD + sc;
    bf16x8 ks0, ks1, vs0, vs1, ks2, ks3, vs2, vs3;
    const int kw0 = sr * 256 + ((sc * 2) ^ ((sr & 7) << 4)), kw1 = (32 + sr) * 256 + ((sc * 2) ^ ((sr & 7) << 4));
    const int vw0 = NA2_V + (((sr >> 3) * 8 + (sc >> 4)) * 256) + (sr & 7) * 32 + (sc & 15) * 2, vw1 = vw0 + 4 * 2048;
#define NA_LOAD2(t_) do { const bf16* p_ = kvb + (size_t)(t_) * 64 * HD; constexpr size_t VO_ = (size_t)NHEAD * GT * HD; ks0 = *(const GAS bf16x8*)(p_); ks1 = *(const GAS bf16x8*)(p_ + 32 * HD); \
        vs0 = *(const GAS bf16x8*)(p_ + VO_); vs1 = *(const GAS bf16x8*)(p_ + VO_ + 32 * HD); \
        if ((t_) + 1 <= thi) { const bf16* q_ = p_ + 64 * HD; ks2 = *(const GAS bf16x8*)(q_); ks3 = *(const GAS bf16x8*)(q_ + 32 * HD); \
            vs2 = *(const GAS bf16x8*)(q_ + VO_); vs3 = *(const GAS bf16x8*)(q_ + VO_ + 32 * HD); } } while (0)
#define NA_WRITE2(B_) do { LAS unsigned char* d_ = L + (B_) * NA2_BUF; *(LAS bf16x8*)(d_ + kw0) = ks0; *(LAS bf16x8*)(d_ + kw1) = ks1; *(LAS bf16x8*)(d_ + vw0) = vs0; *(LAS bf16x8*)(d_ + vw1) = vs1; \
        *(LAS bf16x8*)(d_ + NA2_TILE + kw0) = ks2; *(LAS bf16x8*)(d_ + NA2_TILE + kw1) = ks3; *(LAS bf16x8*)(d_ + NA2_TILE + vw0) = vs2; *(LAS bf16x8*)(d_ + NA2_TILE + vw1) = vs3; } while (0)
    ks2 = ks3 = vs2 = vs3 = (bf16x8){0, 0, 0, 0, 0, 0, 0, 0};
    NA_LOAD2(tlo); NA_WRITE2(0);
    __syncthreads();
    for (int t = tlo; t <= thi; t += 2) {
        const int cur = ((t - tlo) >> 1) & 1;
        if (t + 2 <= thi) NA_LOAD2(t + 2);
        for (int u = 0; u < 2; ++u) { const int tt = t + u;
        if (tt <= thi && tt >= alo && tt <= ahi) {
            const LAS unsigned char* Lb = L + cur * NA2_BUF + u * NA2_TILE; const int lb = (int)(size_t)Lb; const int dro = (tt - rq + 7) * 128;
#pragma unroll
            for (int bq = 0; bq < 2; ++bq) {
                f32x4a p[2];
#pragma unroll
                for (int blk = 0; blk < 2; ++blk) { const LAS float* bp = (const LAS float*)(L + bidx[bq][blk] + dro);
#pragma unroll
                    for (int r = 0; r < 4; ++r) p[blk][r] = ((vmask[bq] >> (4 * blk + r)) & 1u) ? bp[r] : -1e30f;
#pragma unroll
                    for (int s = 0; s < 4; ++s) { const bf16x8 a = *(const LAS bf16x8*)(Lb + koff[bq][blk][s]);
                        p[blk] = __builtin_amdgcn_mfma_f32_16x16x32_bf16(a, qf[bq][s], p[blk], 0, 0, 0); } }
                float pm = fmaxf(fmaxf(fmaxf(p[0][0], p[0][1]), fmaxf(p[0][2], p[0][3])), fmaxf(fmaxf(p[1][0], p[1][1]), fmaxf(p[1][2], p[1][3])));
                pm = fmaxf(pm, __shfl_xor(pm, 16)); pm = fmaxf(pm, __shfl_xor(pm, 32));
                const float mn = fmaxf(m[bq], pm), alpha = ex2(m[bq] - mn); m[bq] = mn;
                float ps = 0.f;
#pragma unroll
                for (int blk = 0; blk < 2; ++blk)
#pragma unroll
                    for (int r = 0; r < 4; ++r) { p[blk][r] = ex2(p[blk][r] - mn); ps += p[blk][r]; }
                l[bq] = l[bq] * alpha + ps;
                if (__any(alpha < 1.0f)) {
#pragma unroll
                    for (int vt = 0; vt < 8; ++vt) o[bq][vt] *= alpha; }
                const bf16x8 pb = mk8(pg8::cvt_pk_bf16(p[0][0], p[0][1]), pg8::cvt_pk_bf16(p[0][2], p[0][3]), pg8::cvt_pk_bf16(p[1][0], p[1][1]), pg8::cvt_pk_bf16(p[1][2], p[1][3]));
                const int va = lb + vbase[bq][0], vb2 = lb + vbase[bq][1];
                s16x4 x0[8], x1[8];
                x0[0] = tr_read_o<0>(va); x1[0] = tr_read_o<0>(vb2); x0[1] = tr_read_o<256>(va); x1[1] = tr_read_o<256>(vb2); x0[2] = tr_read_o<512>(va); x1[2] = tr_read_o<512>(vb2); x0[3] = tr_read_o<768>(va); x1[3] = tr_read_o<768>(vb2);
                x0[4] = tr_read_o<1024>(va); x1[4] = tr_read_o<1024>(vb2); x0[5] = tr_read_o<1280>(va); x1[5] = tr_read_o<1280>(vb2); x0[6] = tr_read_o<1536>(va); x1[6] = tr_read_o<1536>(vb2); x0[7] = tr_read_o<1792>(va); x1[7] = tr_read_o<1792>(vb2);
                asm volatile("s_waitcnt lgkmcnt(0)" ::: "memory"); __builtin_amdgcn_sched_barrier(0);
#pragma unroll
                for (int vt = 0; vt < 8; ++vt) { const bf16x8 av = (bf16x8){x0[vt][0], x0[vt][1], x0[vt][2], x0[vt][3], x1[vt][0], x1[vt][1], x1[vt][2], x1[vt][3]};
                    o[bq][vt] = __builtin_amdgcn_mfma_f32_16x16x32_bf16(av, pb, o[bq][vt], 0, 0, 0); }
            }
        }
        }
        if (t + 2 <= thi) NA_WRITE2(cur ^ 1);
        __syncthreads();
    }
#undef NA_LOAD2
#undef NA_WRITE2
#pragma unroll
    for (int bq = 0; bq < 2; ++bq) { float lt = l[bq]; lt += __shfl_xor(lt, 16); lt += __shfl_xor(lt, 32); const float linv = 1.0f / lt;
#pragma unroll
        for (int vt = 0; vt < 8; ++vt) { const u64 gt = *(const GAS u64*)(sgp[bq] + 16 * vt);
            const unsigned lo = pg8::cvt_pk_bf16(o[bq][vt][0] * linv * bflo((unsigned)gt), o[bq][vt][1] * linv * bfhi((unsigned)gt));
            const unsigned hi = pg8::cvt_pk_bf16(o[bq][vt][2] * linv * bflo((unsigned)(gt >> 32)), o[bq][vt][3] * linv * bfhi((unsigned)(gt >> 32)));
            *(GAS u64*)(ogp[bq] + 16 * vt) = (u64)lo | ((u64)hi << 32); } }
}
constexpr int MM_BUF = 65536, MM_V = 32768;
__device__ __forceinline__ void mem_item2(const Frame& F, const bf16* PROJ, bf16* OG, const bf16* KV, int layer, int g, int tt, int mh) {
    constexpr float LOG2E = 1.4426950408889634f;
    const int W = F.wave, lane = F.lane, tid = F.tid, ql = lane & 15, gq = lane >> 4;
    LAS unsigned char* L = F.lds + RING_OFF;
    const int P = (layer & 1) ? P_B : P_A, QM = (layer & 1) ? QM_B : QM_A, GATE = (layer & 1) ? GATE_B : GATE_A;
    const int tau = tt * 128 + 16 * W + ql, seq = g * 2 + (tt >> 5);
    const bf16* kvb = KV + ((size_t)layer * 2560 + seq * NMEM) * 2048 + mh * MHD;
    __syncthreads();
    bf16x8 qf[8];
#pragma unroll
    for (int s = 0; s < 8; ++s) qf[s] = *(const GAS bf16x8*)(PROJ + (size_t)tau * P + QM + mh * MHD + 32 * s + 8 * gq);
    int koff[4]; int vb0[2], vb1[2];
#pragma unroll
    for (int blk = 0; blk < 4; ++blk) koff[blk] = (16 * blk + ql) * 512;
#pragma unroll
    for (int kk = 0; kk < 2; ++kk) { const int w8 = ((4 * gq + (ql >> 2)) & 7) * 32 + 8 * (ql & 3);
        vb0[kk] = MM_V + (4 * kk + (gq >> 1)) * 4096 + w8; vb1[kk] = MM_V + (4 * kk + 2 + (gq >> 1)) * 4096 + w8; }
    f32x4a o[16];
#pragma unroll
    for (int vt = 0; vt < 16; ++vt) o[vt] = (f32x4a){0.f, 0.f, 0.f, 0.f};
    float m = -1e30f, l = 0.f;
    bf16x8 ks[4], vs[4];
    int srow[4], sch[4];
#pragma unroll
    for (int i = 0; i < 4; ++i) { const int p = tid + 512 * i; srow[i] = p >> 5; sch[i] = p & 31; }
#define MM_LOAD(t_) do { _Pragma("unroll") for (int i = 0; i < 4; ++i) { const bf16* p_ = kvb + (size_t)(64 * (t_) + srow[i]) * 2048 + sch[i] * 8; \
        ks[i] = *(const GAS bf16x8*)(p_); vs[i] = *(const GAS bf16x8*)(p_ + MEMW); } } while (0)
#define MM_WRITE(B_) do { LAS unsigned char* d_ = L + (B_) * MM_BUF; _Pragma("unroll") for (int i = 0; i < 4; ++i) { \
        *(LAS bf16x8*)(d_ + srow[i] * 512 + ((sch[i] * 16) ^ ((srow[i] & 15) << 4))) = ks[i]; \
        *(LAS bf16x8*)(d_ + MM_V + ((srow[i] >> 3) * 16 + (sch[i] >> 1)) * 256 + (srow[i] & 7) * 32 + (sch[i] & 1) * 16) = vs[i]; } } while (0)
    MM_LOAD(0); MM_WRITE(0);
    __syncthreads();
    for (int t = 0; t < 4; ++t) {
        const int cur = t & 1;
        if (t < 3) MM_LOAD(t + 1);
        const LAS unsigned char* Lb = L + cur * MM_BUF; const int lb = (int)(size_t)Lb;
        f32x4a p[4];
#pragma unroll
        for (int blk = 0; blk < 4; ++blk) { p[blk] = (f32x4a){0.f, 0.f, 0.f, 0.f};
#pragma unroll
            for (int s = 0; s < 8; ++s) { const bf16x8 a = *(const LAS bf16x8*)(Lb + koff[blk] + (((4 * s + gq) * 16) ^ (ql << 4)));
                p[blk] = __builtin_amdgcn_mfma_f32_16x16x32_bf16(a, qf[s], p[blk], 0, 0, 0); } }
        float pm = -1e30f;
#pragma unroll
        for (int blk = 0; blk < 4; ++blk)
#pragma unroll
            for (int r = 0; r < 4; ++r) { p[blk][r] *= LOG2E; pm = fmaxf(pm, p[blk][r]); }
        pm = fmaxf(pm, __shfl_xor(pm, 16)); pm = fmaxf(pm, __shfl_xor(pm, 32));
        const float mn = fmaxf(m, pm), alpha = ex2(m - mn); m = mn;
        float ps = 0.f;
#pragma unroll
        for (int blk = 0; blk < 4; ++blk)
#pragma unroll
            for (int r = 0; r < 4; ++r) { p[blk][r] = ex2(p[blk][r] - mn); ps += p[blk][r]; }
        l = l * alpha + ps;
        if (__any(alpha < 1.0f)) {
#pragma unroll
            for (int vt = 0; vt < 16; ++vt) o[vt] *= alpha; }
#pragma unroll
        for (int kk = 0; kk < 2; ++kk) {
            const bf16x8 pb = mk8(pg8::cvt_pk_bf16(p[2 * kk][0], p[2 * kk][1]), pg8::cvt_pk_bf16(p[2 * kk][2], p[2 * kk][3]), pg8::cvt_pk_bf16(p[2 * kk + 1][0], p[2 * kk + 1][1]), pg8::cvt_pk_bf16(p[2 * kk + 1][2], p[2 * kk + 1][3]));
            const int va = lb + vb0[kk], vb2 = lb + vb1[kk];
#define MM_PV4(BASE_) do { s16x4 x0[4], x1[4]; \
                x0[0] = tr_read_o<(BASE_)>(va); x1[0] = tr_read_o<(BASE_)>(vb2); x0[1] = tr_read_o<(BASE_) + 256>(va); x1[1] = tr_read_o<(BASE_) + 256>(vb2); \
                x0[2] = tr_read_o<(BASE_) + 512>(va); x1[2] = tr_read_o<(BASE_) + 512>(vb2); x0[3] = tr_read_o<(BASE_) + 768>(va); x1[3] = tr_read_o<(BASE_) + 768>(vb2); \
                asm volatile("s_waitcnt lgkmcnt(0)" ::: "memory"); __builtin_amdgcn_sched_barrier(0); \
                _Pragma("unroll") for (int v4 = 0; v4 < 4; ++v4) { const bf16x8 av = (bf16x8){x0[v4][0], x0[v4][1], x0[v4][2], x0[v4][3], x1[v4][0], x1[v4][1], x1[v4][2], x1[v4][3]}; \
                    o[(BASE_) / 256 + v4] = __builtin_amdgcn_mfma_f32_16x16x32_bf16(av, pb, o[(BASE_) / 256 + v4], 0, 0, 0); } } while (0)
            MM_PV4(0); MM_PV4(1024); MM_PV4(2048); MM_PV4(3072);
#undef MM_PV4
        }
        if (t < 3) MM_WRITE(cur ^ 1);
        __syncthreads();
    }
#undef MM_LOAD
#undef MM_WRITE
    float lt = l; lt += __shfl_xor(lt, 16); lt += __shfl_xor(lt, 32); const float linv = 1.0f / lt;
    const bf16* sgp = PROJ + (size_t)tau * P + GATE + TOKW + mh * MHD + 4 * gq; bf16* ogp = OG + (size_t)tau * MIXW + TOKW + mh * MHD + 4 * gq;
#pragma unroll
    for (int vt = 0; vt < 16; ++vt) { const u64 gt = *(const GAS u64*)(sgp + 16 * vt);
        const unsigned lo = pg8::cvt_pk_bf16(o[vt][0] * linv * bflo((unsigned)gt), o[vt][1] * linv * bfhi((unsigned)gt));
        const unsigned hi = pg8::cvt_pk_bf16(o[vt][2] * linv * bflo((unsigned)(gt >> 32)), o[vt][3] * linv * bfhi((unsigned)(gt >> 32)));
        *(GAS u64*)(ogp + 16 * vt) = (u64)lo | ((u64)hi << 32); }
}
__device__ __forceinline__ void mem_item(const Frame& F, const bf16* PROJ, bf16* OG, const bf16* KV, int layer, int g, int tt, int mh, int vh) {
    const int W = F.wave, lane = F.lane, n = lane & 31, h = lane >> 5;
    const int P = (layer & 1) ? P_B : P_A, QM = (layer & 1) ? QM_B : QM_A, GATE = (layer & 1) ? GATE_B : GATE_A;
    const int tau = tt * 256 + 32 * W + n, seq = g * 2 + (tt >> 4);
    const bf16* kv = KV + ((size_t)layer * 2560 + seq * NMEM) * 2048;
    attn_item<16, false>(F, PROJ + (size_t)tau * P + QM + mh * MHD + 8 * h, kv, 2048, mh * MHD, MEMW + mh * MHD + vh * 128, 0, 3, 0, 3, 0, 0, 0,
                         OG + (size_t)tau * MIXW + TOKW + mh * MHD + vh * 128, PROJ + (size_t)tau * P + GATE + TOKW + mh * MHD + vh * 128);
}
#define FRESH_FRAME(Fx) Frame Fx = F0; Fx.lane = lane_id_fresh(); Fx.tid = Fx.wave * 64 + Fx.lane
__device__ __forceinline__ void p_mix_naive(const Frame& F0, int layer, int g, int item) {
    if (!(layer & 1)) {
        if (blockIdx.x < 96) { FRESH_FRAME(F); scan_opt(F, FWS(bf16, WS_PROJ), FWS(bf16, WS_OPART), (int)blockIdx.x); }
        else { for (int it = (int)blockIdx.x - 96; it < 256; it += F0.G - 96) {
                   const int pr = it & 7, tl = it >> 3; FRESH_FRAME(F); mem_item2(F, FWS(bf16, WS_PROJ), OGBUF(item), FWS(bf16, WS_KV), layer, g, (pr >> 2) * 32 + tl, pr & 3); } }
    } else {
        for (int k = 0; (int)blockIdx.x + F0.G * k < 768; ++k) {
            const int c = (int)blockIdx.x, it = c + F0.G * k; int pair, rbk;
            if (F0.G == 256) { pair = (c & 7) * 6 + 2 * k + ((c >> 3) >> 4); rbk = (c >> 3) & 15; } else { pair = it >> 4; rbk = it & 15; }
            FRESH_FRAME(F); na_item2(F, FWS(bf16, WS_PROJ), FWS(bf16, WS_OPART), OGBUF(item), FIN(12), layer >> 1, pair / NHEAD, pair % NHEAD, rbk); }
        for (int it = (int)blockIdx.x; it < 256; it += F0.G) { const int pr = it & 7, tl = it >> 3; FRESH_FRAME(F); mem_item2(F, FWS(bf16, WS_PROJ), OGBUF(item), FWS(bf16, WS_KV), layer, g, (pr >> 2) * 32 + tl, pr & 3); }
    }
}

__global__ void __launch_bounds__(NWAVES * 64, 2) fwd(Args args) {
    extern __shared__ __attribute__((aligned(16))) unsigned char lds[];
    Frame F;
    F.lds = (LAS unsigned char*)lds;
    F.MISC = (volatile LAS unsigned*)(F.lds + MISC_OFF);
    F.tid = threadIdx.x; F.lane = F.tid & 63; F.wave = __builtin_amdgcn_readfirstlane(F.tid >> 6); F.G = gridDim.x;
    for (int u = F.tid; u < (LDS_BYTES - LDSCTL_OFF) / 4; u += NWAVES * 64) ((LAS unsigned*)(F.lds + LDSCTL_OFF))[u] = 0u;
    __syncthreads();
    XcdBarrier bar = xcd_barrier_post(FWS(unsigned, WS_CTL) + CW_BAR, F.MISC + 8);
    const int s_lo = args.s_lo, s_hi = args.s_hi;
    int step = 0;
#define IN_STEP() (step >= s_lo && step < s_hi)
#ifndef PROBE_MASK
#define PROBE_MASK 0
#endif
#ifndef PROBE_MULT
#define PROBE_MULT 4
#endif
    unsigned long long pr_acc = 0, pr_last = PROBE_MASK ? rt() : 0ull;
#define SEAM_C(cls) do { if (step >= s_lo && step + 1 < s_hi) xcd_barrier(bar); ++step; \
        if (PROBE_MASK) { const unsigned long long now_ = rt(); if ((PROBE_MASK >> (cls)) & 1) pr_acc += now_ - pr_last; pr_last = now_; } } while (0)
#define SEAM() SEAM_C(0)

    if (IN_STEP()) { p_prologue(F); p_norm(F, 0, 0, 0); }
    SEAM();
    if (IN_STEP()) {
        pg8::Gemm gm{FWS(bf16, WS_MEMH), FWS(bf16, WS_WKV), NLAYER * 2560, 2048, DM}; pg8::KvOrder S{F.G, (int)blockIdx.x}; pg8::EpiKV E{FWS(bf16, WS_KV), 2048, 7};
        pg8::gemm_phase<pg8::EpiKV, pg8::KvOrder, true, true>(F.lds + RING_OFF, gm, S, E, F.wave);
    }
#ifndef DEFER_G2
#define DEFER_G2 1
#endif
#ifndef DEFER_W
#define DEFER_W 64
#endif
#define ITEM_IS_A(it) ((((it) / NGRP) & 1) == 0)
#define GEMM2_CALL(it_) do { const int l2_ = (it_) / NGRP, g2_ = (it_) % NGRP; \
        float* out_ = FOUT(); const float* base_ = l2_ > 0 ? out_ + (size_t)g2_ * GT * DM : (g2_ == 0 ? FIN(0) : FIN(1) + (size_t)(g2_ - 1) * GT * DM); \
        pg8::Gemm gm_{OGBUF(it_), FWS(bf16, WS_WOUT) + (size_t)l2_ * DM * MIXW, GT, DM, MIXW}; pg8::StaticOrder S_; S_.init(GT, DM, F.G, (int)blockIdx.x); \
        pg8::EpiResid E_{base_, out_ + (size_t)g2_ * GT * DM, DM}; \
        pg8::gemm_phase<pg8::EpiResid, pg8::StaticOrder, true, true>(F.lds + RING_OFF, gm_, S_, E_, F.wave); } while (0)
    for (int layer_ = 0; layer_ < NLAYER; ++layer_) {
        for (int g_ = 0; g_ < NGRP; ++g_) {
            if (IN_STEP()) {
                const int layer = opqs(layer_); const int isB = layer & 1, P = isB ? P_B : P_A; const int item = layer * NGRP + opqs(g_);
                const bf16* Bt = isB ? FWS(bf16, WS_WINB) + (size_t)(layer >> 1) * P_B * DM : FWS(bf16, WS_WINA) + (size_t)(layer >> 1) * P_A * DM;
                pg8::Gemm gm{FWS(bf16, WS_H), Bt, GT, P, DM}; pg8::ShiftOrder S; const bool dfr = DEFER_G2 && !isB && item > 0 && F.G == 256; S.init(GT, P, F.G, (int)blockIdx.x, 96, dfr ? DEFER_W : 0);
                pg8::EpiProj E{FWS(bf16, WS_PROJ), P, FWS(float, WS_LBVEC) + (layer >> 1) * 6144, isB, FWS(bf16, WS_OPART), isB ? 36 : 0, 0, GT};
                pg8::gemm_phase<pg8::EpiProj, pg8::ShiftOrder, true, true>(F.lds + RING_OFF, gm, S, E, F.wave);
            }
            SEAM_C(1 + (layer_ & 1));
            if (IN_STEP()) {
                const int layer = opqs(layer_), g = opqs(g_); const int item = layer * NGRP + g;
                if (DEFER_G2 && !(layer & 1) && item > 0 && F.G == 256 && blockIdx.x >= 96 && blockIdx.x < 96 + DEFER_W) GEMM2_CALL(item - 1);
                p_mix_naive(F, layer, g, item);
                const int wg0 = (layer & 1) ? 0 : 96;
                if (g + 1 < NGRP) p_norm(F, layer, g + 1, wg0); else if (layer + 1 < NLAYER) p_norm(F, layer + 1, 0, wg0);
            }
            SEAM_C(3 + (layer_ & 1));
            if (!(layer_ & 1)) {
                if (IN_STEP()) combine_naive(F, opqs(layer_) >> 1, opqs(layer_) * NGRP + opqs(g_));
                SEAM_C(5); }
            if (IN_STEP()) {
                const int item = opqs(layer_) * NGRP + opqs(g_);
                const bool split = DEFER_G2 && (item + 1 < NLAYER * NGRP) && ITEM_IS_A(item + 1) && F.G == 256;
                if (!split || blockIdx.x < 96 || blockIdx.x >= 96 + DEFER_W) GEMM2_CALL(item);
            }
        }
    }
    SEAM_C(6);
    if (IN_STEP()) p_final(F);
    if (PROBE_MASK) { const unsigned long long t0_ = rt(); while (rt() - t0_ < (unsigned long long)PROBE_MULT * pr_acc) __builtin_amdgcn_s_sleep(8); }
#undef IN_STEP
#undef SEAM
}

#ifndef MK_MULTI
#define MK_MULTI 0
#endif
extern "C" void kernel_launch(void* const* d_in, const int* in_sizes, int n_in, void* d_out, int out_size, void* d_ws, size_t ws_size, hipStream_t stream) {
    static int grid = 0;
    if (grid == 0) {
        if (n_in != 14 || out_size != NTOK * DM || ws_size < WS_END) { fprintf(stderr, "kernel_launch: unexpected shapes: n_in %d out %d ws %zu (need %zu)\n", n_in, out_size, ws_size, (size_t)WS_END); grid = -1; return; }
        int dev = 0, cus = 0, per_cu = 0;
        if (hipGetDevice(&dev) != hipSuccess || hipDeviceGetAttribute(&cus, hipDeviceAttributeMultiprocessorCount, dev) != hipSuccess) { grid = -1; return; }
        if (hipFuncSetAttribute((const void*)fwd, hipFuncAttributeMaxDynamicSharedMemorySize, LDS_BYTES) != hipSuccess) { fprintf(stderr, "kernel_launch: hipFuncSetAttribute failed\n"); grid = -1; return; }
        if (hipOccupancyMaxActiveBlocksPerMultiprocessor(&per_cu, (const void*)fwd, NWAVES * 64, LDS_BYTES) != hipSuccess || per_cu < 1) { fprintf(stderr, "kernel_launch: occupancy query says %d\n", per_cu); }
        (void)hipGetLastError();
        grid = cus;
    }
    if (grid < 0) return;
    if (hipMemsetAsync((char*)d_ws + WS_CTL, 0, CTL_ZERO_BYTES, stream) != hipSuccess) return;
    Args a{};
    for (int i = 0; i < 14; ++i) a.in[i] = (const float*)d_in[i];
    a.out = (float*)d_out; a.ws = (unsigned char*)d_ws;
    constexpr int NSTEPS = 3 + (NLAYER / 2) * NGRP * 5;
    if (MK_MULTI) {
        for (int s = 0; s < NSTEPS; ++s) { a.s_lo = s; a.s_hi = s + 1; hipLaunchKernelGGL(fwd, dim3(grid), dim3(NWAVES * 64), LDS_BYTES, stream, a); }
    } else {
        a.s_lo = 0; a.s_hi = 1 << 30; hipLaunchKernelGGL(fwd, dim3(grid), dim3(NWAVES * 64), LDS_BYTES, stream, a);
    }
    const hipError_t le = hipPeekAtLastError();
    if (le != hipSuccess) fprintf(stderr, "kernel_launch: launch failed: %s\n", hipGetErrorName(le));
}
```

```cpp
#include <hip/hip_runtime.h>
#include <cstdio>
#include <cstdint>
namespace pg8 {
#define PG8_LAS __attribute__((address_space(3)))
typedef unsigned short bf16_t;
typedef short bf16x8 __attribute__((ext_vector_type(8)));
typedef float f32x4 __attribute__((ext_vector_type(4)));
typedef unsigned u32x4 __attribute__((ext_vector_type(4)));
constexpr int BM = 256, BK = 64, HALF = 128, HTB = HALF * BK * 2  , STAGE_BYTES = 8 * HTB, NXCD = 8, WGM = 4;

__host__ __device__ __forceinline__ int lds_byte(int r, int c) { const int st = (r >> 4) * 2 + (c >> 5), rr = r & 15, cc = c & 31, ob = rr * 64 + cc * 2; return st * 1024 + (ob ^ (((ob >> 9) & 1) << 5)); }
__host__ __device__ __forceinline__ void stage_rc(int b, int& R, int& C) { const int st = b / 1024, sb = b % 1024, swz = sb ^ (((sb >> 9) & 1) << 5); R = (st >> 1) * 16 + swz / 64; C = (st & 1) * 32 + (swz % 64) / 2; }
__host__ __device__ __forceinline__ int perm32(int rho) { const int n = rho >> 4, i = rho & 15; return 8 * (i >> 2) + 4 * n + (i & 3); }

struct Unit { int pm, pn; };
struct Gemm { const bf16_t* A; const bf16_t* Bt; int M, N, K; };

struct StaticOrder {
    int nM, nN, nwg, G, c;
    __host__ __device__ void init(int M, int N, int G_, int c_) { nM = M / BM; nN = N / BM; nwg = nM * nN; G = G_; c = c_; }
    __host__ __device__ bool next(int i, Unit& u) const {
        const long L = (long)i * G + c; if (L >= nwg) return false;
        int wgid = (int)L; { const int q = nwg / NXCD, r = nwg % NXCD, xcd = wgid % NXCD, off = wgid / NXCD; wgid = (xcd < r ? xcd * (q + 1) : r * (q + 1) + (xcd - r) * q) + off; }
        const int nig = WGM * nN, gid = wgid / nig, fm = gid * WGM, gsz = (nM - fm) < WGM ? (nM - fm) : WGM;
        u.pm = fm + ((wgid % nig) % gsz); u.pn = (wgid % nig) / gsz; return true;
    }
    __device__ __forceinline__ void a_ready(const Unit&) const {}
    __device__ __forceinline__ void done(const Unit&) const {}
};
typedef __bf16 bf16v2_t __attribute__((ext_vector_type(2)));
__device__ __forceinline__ unsigned cvt_pk_bf16(float lo, float hi) { bf16v2_t v; v.x = (__bf16)lo; v.y = (__bf16)hi; return __builtin_bit_cast(unsigned, v); }
typedef float f32x2 __attribute__((ext_vector_type(2)));
__device__ __forceinline__ float fast_sigmoid(float x) { return __builtin_amdgcn_rcpf(1.0f + __expf(-x)); }
__device__ __forceinline__ float proj_act(float x, int mode, float sc, float lb) {
    if (mode == 0) return x * sc;
    const float s = fast_sigmoid(x);
    if (mode == 1) return x * s * sc;
    const float f = lb + (1.0f - lb) * s;
    return fmaxf(__logf(f), -80.0f);
}
struct EpiProj {
    static constexpr bool PERM = true, AFTER_DRAIN = false;
    bf16_t* O; int ldc; const float* lb; int layerB; bf16_t* HB; int hm_tiles, tm_col0, hm_rows;
    __device__ __forceinline__ void operator()(const f32x4 (&acc)[2][2][4][2], const Unit& u, int wr, int wc, int fr, int fq) const {
        const int row0 = u.pm * BM + wr * 64 + fr;
        int mode = 0; float sc = 1.0f; int lboff = 0;
        if (!layerB) {
            if (u.pn < 12) { mode = 1; sc = 0.08838834764831845f; }
            else if (u.pn < 36) { mode = 2; lboff = (u.pn - 12) * BM; }
            else if (u.pn < 48) { mode = 0; }
            else if (u.pn < 52) { mode = 0; sc = 0.0625f; }
            else { mode = 1; }
        } else {
            if (u.pn < 12) { mode = 0; sc = 0.12751743074602254f; }
            else if (u.pn < 36) { mode = 0; }
            else if (u.pn < 40) { mode = 0; sc = 0.0625f; }
            else { mode = 1; }
        }
        bf16_t* sb; size_t rstr, bjstr;
        if (u.pn < hm_tiles) { sb = HB + (size_t)(2 * u.pn) * hm_rows * 128 + wc * 32 + 8 * fq; rstr = 128; bjstr = (size_t)hm_rows * 128; }
        else { sb = O + (u.pn * BM - tm_col0) + wc * 32 + 8 * fq; rstr = (size_t)ldc; bjstr = HALF; }
        if (mode == 2) {
            f32x4 lbv[2][2];
#pragma unroll
            for (int bj = 0; bj < 2; ++bj)
#pragma unroll
                for (int n = 0; n < 2; ++n) lbv[bj][n] = *(const f32x4*)(lb + lboff + wc * 32 + 8 * fq + bj * HALF + 4 * n);
#pragma unroll
            for (int ai = 0; ai < 2; ++ai)
#pragma unroll
                for (int m = 0; m < 4; ++m) { bf16_t* rowp = sb + (size_t)(row0 + ai * HALF + m * 16) * rstr;
#pragma unroll
                    for (int bj = 0; bj < 2; ++bj) { f32x4 v0 = acc[ai][bj][m][0], v1 = acc[ai][bj][m][1];
#pragma unroll
                        for (int j = 0; j < 4; ++j) { v0[j] = proj_act(v0[j], 2, 1.0f, lbv[bj][0][j]); v1[j] = proj_act(v1[j], 2, 1.0f, lbv[bj][1][j]); }
                        u32x4 w; w.x = cvt_pk_bf16(v0[0], v0[1]); w.y = cvt_pk_bf16(v0[2], v0[3]); w.z = cvt_pk_bf16(v1[0], v1[1]); w.w = cvt_pk_bf16(v1[2], v1[3]);
                        *(u32x4*)(rowp + bj * bjstr) = w; } }
        } else if (mode == 1) {
#pragma unroll
            for (int ai = 0; ai < 2; ++ai)
#pragma unroll
                for (int m = 0; m < 4; ++m) { bf16_t* rowp = sb + (size_t)(row0 + ai * HALF + m * 16) * rstr;
#pragma unroll
                    for (int bj = 0; bj < 2; ++bj) { f32x4 v0 = acc[ai][bj][m][0], v1 = acc[ai][bj][m][1];
#pragma unroll
                        for (int j = 0; j < 4; ++j) { v0[j] = proj_act(v0[j], 1, sc, 0.f); v1[j] = proj_act(v1[j], 1, sc, 0.f); }
                        u32x4 w; w.x = cvt_pk_bf16(v0[0], v0[1]); w.y = cvt_pk_bf16(v0[2], v0[3]); w.z = cvt_pk_bf16(v1[0], v1[1]); w.w = cvt_pk_bf16(v1[2], v1[3]);
                        *(u32x4*)(rowp + bj * bjstr) = w; } }
        } else {
#pragma unroll
            for (int ai = 0; ai < 2; ++ai)
#pragma unroll
                for (int m = 0; m < 4; ++m) { bf16_t* rowp = sb + (size_t)(row0 + ai * HALF + m * 16) * rstr;
#pragma unroll
                    for (int bj = 0; bj < 2; ++bj) { const f32x4 v0 = acc[ai][bj][m][0] * sc, v1 = acc[ai][bj][m][1] * sc;
                        u32x4 w; w.x = cvt_pk_bf16(v0[0], v0[1]); w.y = cvt_pk_bf16(v0[2], v0[3]); w.z = cvt_pk_bf16(v1[0], v1[1]); w.w = cvt_pk_bf16(v1[2], v1[3]);
                        *(u32x4*)(rowp + bj * bjstr) = w; } }
        }
    }
};
struct EpiKV {
    static constexpr bool PERM = true, AFTER_DRAIN = false;
    bf16_t* O; int ldc; int cmask;
    __device__ __forceinline__ void operator()(const f32x4 (&acc)[2][2][4][2], const Unit& u, int wr, int wc, int fr, int fq) const {
        const int row0 = u.pm * BM + wr * 64 + fr, col0 = (u.pn & cmask) * BM + wc * 32 + 8 * fq;
#pragma unroll
        for (int ai = 0; ai < 2; ++ai)
#pragma unroll
            for (int m = 0; m < 4; ++m) { bf16_t* rowp = O + (size_t)(row0 + ai * HALF + m * 16) * ldc + col0;
#pragma unroll
                for (int bj = 0; bj < 2; ++bj) { const f32x4 v0 = acc[ai][bj][m][0], v1 = acc[ai][bj][m][1];
                    u32x4 w; w.x = cvt_pk_bf16(v0[0], v0[1]); w.y = cvt_pk_bf16(v0[2], v0[3]); w.z = cvt_pk_bf16(v1[0], v1[1]); w.w = cvt_pk_bf16(v1[2], v1[3]);
                    *(u32x4*)(rowp + bj * HALF) = w; } }
    }
};
struct EpiResid {
    static constexpr bool PERM = false, AFTER_DRAIN = false;
    const float* base; float* out; int ldc;
    __device__ __forceinline__ void operator()(const f32x4 (&acc)[2][2][4][2], const Unit& u, int wr, int wc, int fr, int fq) const {
        const int row0 = u.pm * BM + wr * 64 + fr, col0 = u.pn * BM + wc * 32 + 4 * fq;
#pragma unroll
        for (int ai = 0; ai < 2; ++ai)
#pragma unroll
            for (int m = 0; m < 4; ++m) { const size_t off = (size_t)(row0 + ai * HALF + m * 16) * ldc + col0;
#pragma unroll
                for (int bj = 0; bj < 2; ++bj)
#pragma unroll
                    for (int n = 0; n < 2; ++n) { const f32x4 b = *(const f32x4*)(base + off + bj * HALF + n * 16); *(f32x4*)(out + off + bj * HALF + n * 16) = b + acc[ai][bj][m][n]; } }
    }
};
struct KvOrder {
    int G, c;
    __device__ __forceinline__ bool next(int i, Unit& u) const {
        const int L = i * G + c; if (L >= 320) return false;
        const int layer = L / 80, rem = L % 80; u.pm = layer * 10 + (rem >> 3); u.pn = layer * 8 + (rem & 7); return true;
    }
    __device__ __forceinline__ void a_ready(const Unit&) const {}
    __device__ __forceinline__ void done(const Unit&) const {}
};
struct ShiftOrder {
    int nM, nN, nwg, G, c, shift, width;
    __device__ __forceinline__ void init(int M, int N, int G_, int c_, int shift_, int width_) { nM = M / BM; nN = N / BM; nwg = nM * nN; G = G_; c = c_; shift = shift_; width = width_; }
    __device__ __forceinline__ bool next(int i, Unit& u) const {
        const int R = nwg / G; long L;
        if (i < R) L = (long)i * G + c;
        else if (width == 0) { L = (long)i * G + c; if (L >= nwg) return false; }
        else { if (c < shift || c >= shift + width) return false; L = (long)R * G + (long)(i - R) * width + (c - shift); if (L >= nwg) return false; }
        int wgid = (int)L; { const int q = nwg / NXCD, r = nwg % NXCD, xcd = wgid % NXCD, off = wgid / NXCD; wgid = (xcd < r ? xcd * (q + 1) : r * (q + 1) + (xcd - r) * q) + off; }
        const int nig = WGM * nN, gid = wgid / nig, fm = gid * WGM, gsz = (nM - fm) < WGM ? (nM - fm) : WGM;
        u.pm = fm + ((wgid % nig) % gsz); u.pn = (wgid % nig) / gsz; return true;
    }
    __device__ __forceinline__ void a_ready(const Unit&) const {}
    __device__ __forceinline__ void done(const Unit&) const {}
};
template <class Epi, class Sched, bool ALIGN_EPI = false, bool SP2 = false>
__device__ __forceinline__ void gemm_phase(PG8_LAS unsigned char* lds, const Gemm g, const Sched& S, const Epi& E, int wave_in) {
    int lane_; asm volatile("v_mbcnt_lo_u32_b32 %0, -1, 0\n\tv_mbcnt_hi_u32_b32 %0, -1, %0" : "=v"(lane_)); const int tid = wave_in * 64 + lane_, wid = __builtin_amdgcn_readfirstlane(tid >> 6), lane = tid & 63, wr = wid >> 2, wc = wid & 3, fr = lane & 15, fq = lane >> 4;
    const int K = g.K, nt = K / BK;
    unsigned voffA[2], voffB[2];
#pragma unroll
    for (int i = 0; i < 2; ++i) { int R, C; stage_rc(tid * 16 + i * 8192, R, C); const int Rb = Epi::PERM ? ((R & ~31) + perm32(R & 31)) : R;
        voffA[i] = (unsigned)(R * K + C) * 2u; voffB[i] = (unsigned)(Rb * K + C) * 2u; }
    const size_t kstep = (size_t)(BK * 2);
    const size_t hstep = (size_t)HALF * K * 2;
    const size_t tstep = 2 * hstep;
    const unsigned ldsw = (unsigned)wid * 1024u;
    const int aoff = lds_byte(wr * 64 + fr, fq * 8), boff = lds_byte(wc * 32 + fr, fq * 8);
#define PG8_SA(b, h) (((b) * 2 + (h)) * HTB)
#define PG8_SB(b, h) ((4 + (b) * 2 + (h)) * HTB)
#define PG8_STAGE(bufoff, gbase, voff) do { _Pragma("unroll") for (int _i = 0; _i < 2; ++_i) \
        __builtin_amdgcn_global_load_lds((const unsigned*)((const char*)(gbase) + (voff)[_i]), (PG8_LAS unsigned*)(lds + (bufoff) + ldsw + _i * 8192), 16, 0, 0); } while (0)
#define PG8_LDA(dst, b, h) do { _Pragma("unroll") for (int m = 0; m < 4; ++m) _Pragma("unroll") for (int k = 0; k < 2; ++k) dst[m][k] = *(const PG8_LAS bf16x8*)(lds + PG8_SA(b, h) + aoff + m * 2048 + k * 1024); } while (0)
#define PG8_LDB(dst, b, h) do { _Pragma("unroll") for (int n = 0; n < 2; ++n) _Pragma("unroll") for (int k = 0; k < 2; ++k) dst[n][k] = *(const PG8_LAS bf16x8*)(lds + PG8_SB(b, h) + boff + n * 2048 + k * 1024); } while (0)
#define PG8_MMA(ai, bj, At, Bt) do { __builtin_amdgcn_s_setprio(1); _Pragma("unroll") for (int m = 0; m < 4; ++m) _Pragma("unroll") for (int n = 0; n < 2; ++n) _Pragma("unroll") for (int k = 0; k < 2; ++k) \
        acc[ai][bj][m][n] = __builtin_amdgcn_mfma_f32_16x16x32_bf16(Bt[n][k], At[m][k], acc[ai][bj][m][n], 0, 0, 0); __builtin_amdgcn_s_setprio(0); } while (0)
#define PG8_WAIT_V(n) asm volatile("s_waitcnt vmcnt(" #n ")" ::: "memory")
#define PG8_WAIT_L(n) asm volatile("s_waitcnt lgkmcnt(" #n ")" ::: "memory")
#define PG8_BAR __builtin_amdgcn_s_barrier()
#define PG8_SCHED __builtin_amdgcn_sched_barrier(0)
    Unit cur, nxt; int ui = 0;
    if (!S.next(0, cur)) return;
    f32x4 acc[2][2][4][2];
#pragma unroll
    for (int a = 0; a < 2; ++a)
#pragma unroll
        for (int b = 0; b < 2; ++b)
#pragma unroll
            for (int m = 0; m < 4; ++m)
#pragma unroll
                for (int n = 0; n < 2; ++n) acc[a][b][m][n] = (f32x4){0.f, 0.f, 0.f, 0.f};
    bf16x8 At[4][2], B0[2][2], B1[2][2];
    const char* cA = (const char*)g.A + (size_t)cur.pm * tstep; const char* cB = (const char*)g.Bt + (size_t)cur.pn * tstep;
    S.a_ready(cur);
    if constexpr (SP2) {
        PG8_STAGE(PG8_SB(0, 0), cB, voffB); PG8_STAGE(PG8_SB(0, 1), cB + hstep, voffB); PG8_STAGE(PG8_SA(0, 0), cA, voffA); PG8_STAGE(PG8_SA(0, 1), cA + hstep, voffA);
        if (wr == 1) PG8_BAR;
        PG8_WAIT_V(2); PG8_BAR;
        PG8_STAGE(PG8_SB(1, 0), cB + kstep, voffB); PG8_STAGE(PG8_SA(1, 0), cA + kstep, voffA); PG8_STAGE(PG8_SB(1, 1), cB + hstep + kstep, voffB);
        PG8_WAIT_V(6); PG8_BAR;
    } else {
        PG8_STAGE(PG8_SB(0, 0), cB, voffB); PG8_STAGE(PG8_SA(0, 0), cA, voffA); PG8_STAGE(PG8_SB(0, 1), cB + hstep, voffB); PG8_STAGE(PG8_SA(0, 1), cA + hstep, voffA);
        if (wr == 1) PG8_BAR;
        PG8_WAIT_V(4); PG8_BAR;
        PG8_STAGE(PG8_SB(1, 0), cB + kstep, voffB); PG8_STAGE(PG8_SA(1, 0), cA + kstep, voffA); PG8_STAGE(PG8_SB(1, 1), cB + hstep + kstep, voffB);
        PG8_WAIT_V(6); PG8_BAR;
    }
    for (;;) {
        const bool has_next = S.next(ui + 1, nxt);
        const char* nA = has_next ? (const char*)g.A + (size_t)nxt.pm * tstep : cA; const char* nB = has_next ? (const char*)g.Bt + (size_t)nxt.pn * tstep : cB;
        for (int t = 0; t < nt; t += 2) {
            const bool last = (t == nt - 2);
            const char* a1 = cA + (size_t)(t + 1) * kstep;
            const char* a2 = last ? nA : cA + (size_t)(t + 2) * kstep; const char* b2 = last ? nB : cB + (size_t)(t + 2) * kstep;
            const char* a3 = a2 + kstep; const char* b3 = b2 + kstep;
            if (last && has_next) S.a_ready(nxt);
            if constexpr (SP2) {
            PG8_LDB(B0, 0, 0); PG8_LDB(B1, 0, 1); PG8_SCHED; PG8_LDA(At, 0, 0); PG8_STAGE(PG8_SA(1, 1), a1 + hstep, voffA);
            PG8_WAIT_V(8); PG8_WAIT_L(0); PG8_BAR; PG8_MMA(0, 0, At, B0); PG8_MMA(0, 1, At, B1); PG8_BAR; PG8_SCHED;
            PG8_LDA(At, 0, 1); PG8_STAGE(PG8_SB(0, 0), b2, voffB); PG8_STAGE(PG8_SB(0, 1), b2 + hstep, voffB); PG8_STAGE(PG8_SA(0, 0), a2, voffA);
            PG8_WAIT_V(8); PG8_WAIT_L(0); PG8_BAR; PG8_MMA(1, 0, At, B0); PG8_MMA(1, 1, At, B1); PG8_BAR; PG8_SCHED;
            PG8_LDB(B0, 1, 0); PG8_LDB(B1, 1, 1); PG8_SCHED; PG8_LDA(At, 1, 0); PG8_STAGE(PG8_SA(0, 1), a2 + hstep, voffA);
            PG8_WAIT_V(8); PG8_WAIT_L(0); PG8_BAR; PG8_MMA(0, 0, At, B0); PG8_MMA(0, 1, At, B1); PG8_BAR; PG8_SCHED;
            PG8_LDA(At, 1, 1); PG8_STAGE(PG8_SB(1, 0), b3, voffB); PG8_STAGE(PG8_SB(1, 1), b3 + hstep, voffB); PG8_STAGE(PG8_SA(1, 0), a3, voffA);
            PG8_WAIT_V(8); PG8_WAIT_L(0); PG8_BAR; PG8_MMA(1, 0, At, B0); PG8_MMA(1, 1, At, B1); PG8_BAR; PG8_SCHED;
            } else {
            PG8_LDB(B0, 0, 0); PG8_SCHED; PG8_LDA(At, 0, 0); PG8_STAGE(PG8_SA(1, 1), a1 + hstep, voffA);
            PG8_WAIT_L(8); PG8_BAR; PG8_WAIT_L(0); PG8_MMA(0, 0, At, B0); PG8_BAR; PG8_SCHED;
            PG8_LDB(B1, 0, 1); PG8_STAGE(PG8_SB(0, 0), b2, voffB);
            PG8_BAR; PG8_WAIT_L(0); PG8_MMA(0, 1, At, B1); PG8_BAR;
            PG8_LDA(At, 0, 1); PG8_STAGE(PG8_SA(0, 0), a2, voffA);
            PG8_BAR; PG8_WAIT_L(0); PG8_MMA(1, 0, At, B0); PG8_BAR; PG8_SCHED;
            PG8_STAGE(PG8_SB(0, 1), b2 + hstep, voffB);
            PG8_WAIT_V(6); PG8_BAR; PG8_MMA(1, 1, At, B1); PG8_BAR;
            PG8_LDB(B0, 1, 0); PG8_SCHED; PG8_LDA(At, 1, 0); PG8_STAGE(PG8_SA(0, 1), a2 + hstep, voffA);
            PG8_WAIT_L(8); PG8_BAR; PG8_WAIT_L(0); PG8_MMA(0, 0, At, B0); PG8_BAR; PG8_SCHED;
            PG8_LDB(B1, 1, 1); PG8_STAGE(PG8_SB(1, 0), b3, voffB);
            PG8_BAR; PG8_WAIT_L(0); PG8_MMA(0, 1, At, B1); PG8_BAR;
            PG8_LDA(At, 1, 1); PG8_STAGE(PG8_SA(1, 0), a3, voffA);
            PG8_BAR; PG8_WAIT_L(0); PG8_MMA(1, 0, At, B0); PG8_BAR; PG8_SCHED;
            PG8_STAGE(PG8_SB(1, 1), b3 + hstep, voffB);
            PG8_WAIT_V(6); PG8_BAR; PG8_MMA(1, 1, At, B1); PG8_BAR;
            }
        }
        if constexpr (ALIGN_EPI) { if (wr == 0) PG8_BAR; }
        if constexpr (!Epi::AFTER_DRAIN) { E(acc, cur, wr, wc, fr, fq); S.done(cur); }
        if (!has_next) break;
#pragma unroll
        for (int a = 0; a < 2; ++a)
#pragma unroll
            for (int b = 0; b < 2; ++b)
#pragma unroll
                for (int m = 0; m < 4; ++m)
#pragma unroll
                    for (int n = 0; n < 2; ++n) acc[a][b][m][n] = (f32x4){0.f, 0.f, 0.f, 0.f};
        cur = nxt; cA = nA; cB = nB; ++ui;
        if constexpr (ALIGN_EPI) { if (wr == 1) PG8_BAR; }
    }
    PG8_WAIT_V(0);
    if constexpr (!ALIGN_EPI) { if (wr == 0) PG8_BAR; }
    PG8_BAR;
    if constexpr (Epi::AFTER_DRAIN) { E.fused(acc, cur, wr, wc, fr, fq, lds, wid, lane); S.done(cur); }
#undef PG8_SA
#undef PG8_SB
#undef PG8_STAGE
#undef PG8_LDA
#undef PG8_LDB
#undef PG8_MMA
#undef PG8_WAIT_V
#undef PG8_WAIT_L
#undef PG8_BAR
#undef PG8_SCHED
}
}
#define GAS __attribute__((address_space(1)))
#define LAS __attribute__((address_space(3)))
typedef unsigned short bf16;
typedef unsigned v4u __attribute__((ext_vector_type(4)));
typedef float f32x4 __attribute__((ext_vector_type(4)));
typedef short bf16x8 __attribute__((ext_vector_type(8)));
typedef GAS unsigned gu32;
typedef GAS unsigned long long gu64;
#define RLX_AGENT __ATOMIC_RELAXED, __HIP_MEMORY_SCOPE_AGENT
#define LDS_WAIT() asm volatile("s_waitcnt lgkmcnt(0)" ::: "memory")
#define VM_WAIT() asm volatile("s_waitcnt vmcnt(0)" ::: "memory")
__device__ __forceinline__ unsigned long long rt() { return __builtin_amdgcn_s_memrealtime(); }
__device__ __forceinline__ unsigned f2bf(float f) { unsigned u = __builtin_bit_cast(unsigned, f); return (u + 0x7fffu + ((u >> 16) & 1u)) >> 16; }
__device__ __forceinline__ unsigned pk2(float lo, float hi) { return f2bf(lo) | (f2bf(hi) << 16); }
#define XB_TMO      128
#define XB_XCNT(j)  (256  + 64 * (j))
#define XB_XSUB(j)  (1280 + 64 * (j))
#define XB_XGEN(j)  (2304 + 64 * (j))
#define XB_TOP      3328
#define XB_TOPGEN   3392
#define XCD_BAR_WORDS 3456
#define XB_SPIN_CAP (1u << 22)

__device__ __forceinline__ unsigned xb_ld(unsigned* p)              { return __hip_atomic_load(p, __ATOMIC_RELAXED, __HIP_MEMORY_SCOPE_AGENT); }
__device__ __forceinline__ unsigned xb_add(unsigned* p, unsigned v) { return __hip_atomic_fetch_add(p, v, __ATOMIC_RELAXED, __HIP_MEMORY_SCOPE_AGENT); }
__device__ __forceinline__ unsigned xb_xcc_id() { return (unsigned)__builtin_amdgcn_s_getreg((3 << 11) | 20) & 0xFu; }
#define XB_SPIN(cond, bar) do { unsigned _sp = 0; while (cond) { __builtin_amdgcn_s_sleep(1); \
    if ((++_sp & 255u) == 0u) { if (xb_ld(&(bar)[XB_TMO])) break; if (_sp > XB_SPIN_CAP) { atomicAdd(&(bar)[XB_TMO], 1u); break; } } } } while (0)

struct XcdBarrier {
    unsigned* bar; unsigned x;
    volatile LAS unsigned* st;
};

__device__ __forceinline__ XcdBarrier xcd_barrier_post(unsigned* bar, volatile LAS unsigned* st) {
    XcdBarrier b; b.bar = bar; b.x = xb_xcc_id(); b.st = st;
    if (threadIdx.x == 0) (void)xb_add(&bar[XB_XCNT(b.x)], 1u);
    return b;
}
__device__ __forceinline__ void xcd_barrier_complete(unsigned* bar, unsigned x, unsigned& nloc, unsigned& nx) {
    const unsigned G = gridDim.x * gridDim.y * gridDim.z;
    unsigned sum, cnt, mine, sp = 0u;
    for (;;) {
        sum = 0u; cnt = 0u; mine = 0u;
#pragma unroll
        for (unsigned j = 0; j < 16; ++j) { const unsigned c = xb_ld(&bar[XB_XCNT(j)]); sum += c; cnt += (c > 0u) ? 1u : 0u; mine = (j == x) ? c : mine; }
        if (sum == G) break;
        __builtin_amdgcn_s_sleep(1);
        if ((++sp & 255u) == 0u) { if (xb_ld(&bar[XB_TMO])) break; if (sp > XB_SPIN_CAP) { atomicAdd(&bar[XB_TMO], 1u); break; } }
    }
    nloc = mine > 0u ? mine : 1u; nx = cnt > 0u ? cnt : 1u;
}

__device__ __forceinline__ void xcd_barrier(const XcdBarrier& b) {
    asm volatile("s_waitcnt vmcnt(0)" ::: "memory");
    __syncthreads();
    if (threadIdx.x == 0) {
        unsigned* bar = b.bar;
        __builtin_amdgcn_s_waitcnt(0);
        unsigned nloc = b.st[0], nx = b.st[1];
        if (nloc == 0u) { xcd_barrier_complete(bar, b.x, nloc, nx); b.st[0] = nloc; b.st[1] = nx; }
        const unsigned old = xb_add(&bar[XB_XSUB(b.x)], 1u);
        const unsigned gen = old / nloc;
        if (old + 1u == (gen + 1u) * nloc) {
            __builtin_amdgcn_fence(__ATOMIC_RELEASE, "agent");
            asm volatile("s_waitcnt vmcnt(0)" ::: "memory");
            const unsigned og = xb_add(&bar[XB_TOP], 1u);
            const unsigned tg = og / nx;
            if (og + 1u == (tg + 1u) * nx) xb_add(&bar[XB_TOPGEN], 1u);
            else XB_SPIN(xb_ld(&bar[XB_TOPGEN]) == tg, bar);
            __builtin_amdgcn_fence(__ATOMIC_ACQUIRE, "agent");
            xb_add(&bar[XB_XGEN(b.x)], 1u);
            asm volatile("s_waitcnt vmcnt(0)" ::: "memory");
        } else {
            XB_SPIN(xb_ld(&bar[XB_XGEN(b.x)]) == gen, bar);
            __builtin_amdgcn_fence(__ATOMIC_ACQUIRE, "agent");
            asm volatile("s_waitcnt vmcnt(0)" ::: "memory");
        }
    }
    __syncthreads();
}
constexpr int NWAVES = 8;
constexpr int DM = 2048, SEQ = 4096, NSEQ = 10, NTOK = NSEQ * SEQ, NGRP = 5, GT = NTOK / NGRP  ;
constexpr int P_A = 17408, P_B = 14336, TOKW = 3072, MEMW = 1024, MIXW = 4096, NMEM = 256, NHEAD = 24, HD = 128, MHEADS = 4, MHD = 256;
constexpr int QM_A = 12288, GATE_A = 13312, QM_B = 9216, GATE_B = 10240;
constexpr int NLAYER = 4;
constexpr float EPS = 1e-6f;
constexpr size_t MiB = 1u << 20;
constexpr size_t WS_CTL = 0, CTL_ZERO_BYTES = 1 * MiB;
constexpr size_t WS_LBVEC = 1 * MiB;
constexpr size_t WS_WINA = 2 * MiB;
constexpr size_t WS_WINB = 138 * MiB;
constexpr size_t WS_WOUT = 250 * MiB;
constexpr size_t WS_WKV  = 314 * MiB;
constexpr size_t WS_MEMH = 346 * MiB;
constexpr size_t WS_KV   = 386 * MiB;
constexpr size_t WS_H    = 426 * MiB;
constexpr size_t WS_PROJ = 458 * MiB;
constexpr size_t WS_OG   = 730 * MiB;
constexpr size_t WS_OPART= 794 * MiB;
constexpr size_t WS_OG2  = 986 * MiB;
constexpr size_t WS_END  = 1050 * MiB;
constexpr int CW_BAR = 4096;
constexpr int RING_OFF = 0, RING_BYTES = 131072;
constexpr int LDSCTL_OFF = RING_BYTES, MISC_OFF = LDSCTL_OFF + 320;
constexpr int LDS_BYTES = 147456;

struct Args { const float* in[14]; float* out; unsigned char* ws; int s_lo, s_hi; };
struct Frame {
    LAS unsigned char* lds;
    volatile LAS unsigned* MISC;
    int tid, lane, wave, G;
};
typedef const __attribute__((address_space(4))) Args* KArgsP;
__device__ __forceinline__ KArgsP kargs() { KArgsP p = (KArgsP)__builtin_amdgcn_kernarg_segment_ptr(); asm volatile("" : "+s"(p)); return p; }
__device__ __forceinline__ int lane_id_fresh() { int l; asm volatile("v_mbcnt_lo_u32_b32 %0, -1, 0\n\tv_mbcnt_hi_u32_b32 %0, -1, %0" : "=v"(l)); return l; }
__device__ __forceinline__ int opqs(int x) { asm volatile("" : "+s"(x)); return x; }
#define FIN(k) (kargs()->in[k])
#define FOUT() (kargs()->out)
#define FWS(T, off) ((T*)(kargs()->ws + (off)))
#define OGBUF(item) ((item) & 1 ? FWS(bf16, WS_OG2) : FWS(bf16, WS_OG))

__device__ __forceinline__ float wave_sum(float v) {
#pragma unroll
    for (int o = 1; o < 64; o <<= 1) v += __shfl_xor(v, o);
    return v;
}
__device__ __forceinline__ float wave_max(float v) {
#pragma unroll
    for (int o = 1; o < 64; o <<= 1) v = fmaxf(v, __shfl_xor(v, o));
    return v;
}
__device__ __forceinline__ float bf2f(unsigned short b) { return __uint_as_float(((unsigned)b) << 16); }
__device__ __forceinline__ float bflo(unsigned w) { return __uint_as_float(w << 16); }
__device__ __forceinline__ float bfhi(unsigned w) { return __uint_as_float(w & 0xffff0000u); }

__device__ __forceinline__ void p0_transpose_item(const float* W, int K, int N, bf16* WT, LAS float* scr, int item, int lane) {
    const int nblk = N / 32, kb = item / nblk, nb = item % nblk, k0 = 64 * kb, n0 = 32 * nb;
#pragma unroll 8
    for (int i = 0; i < 32; ++i) { const int kk = 2 * i + (lane >> 5); scr[kk * 33 + (lane & 31)] = W[(size_t)(k0 + kk) * N + n0 + (lane & 31)]; }
    LDS_WAIT(); asm volatile("" ::: "memory");
    const int c = lane & 7;
#pragma unroll
    for (int j = 0; j < 4; ++j) { const int n = (lane >> 3) + 8 * j; const LAS float* s = scr + (8 * c) * 33 + n;
        v4u o; o.x = pk2(s[0 * 33], s[1 * 33]); o.y = pk2(s[2 * 33], s[3 * 33]); o.z = pk2(s[4 * 33], s[5 * 33]); o.w = pk2(s[6 * 33], s[7 * 33]);
        *(GAS v4u*)(WT + (size_t)(n0 + n) * K + k0 + 8 * c) = o; }
    LDS_WAIT(); asm volatile("" ::: "memory");
}
__device__ __forceinline__ void rms_row_bf16(const float* xrow, const float* g, bf16* orow, int lane) {
    const GAS f32x4* xr = (const GAS f32x4*)xrow + lane;
    f32x4 v[8]; float s = 0.f;
#pragma unroll
    for (int j = 0; j < 8; ++j) { v[j] = xr[64 * j]; s += (v[j].x * v[j].x + v[j].y * v[j].y) + (v[j].z * v[j].z + v[j].w * v[j].w); }
    const float r = rsqrtf(wave_sum(s) * (1.f / DM) + EPS);
    const GAS f32x4* gr = (const GAS f32x4*)g + lane;
    GAS unsigned long long* o8 = (GAS unsigned long long*)orow + lane;
#pragma unroll
    for (int j = 0; j < 8; ++j) { const f32x4 gv = gr[64 * j]; const f32x4 y = v[j] * r * gv;
        o8[64 * j] = (unsigned long long)pg8::cvt_pk_bf16(y.x, y.y) | ((unsigned long long)pg8::cvt_pk_bf16(y.z, y.w) << 32); }
}
__device__ __forceinline__ void rms_row_f32_inplace(float* xrow, const float* g, int lane) {
    GAS f32x4* xr = (GAS f32x4*)xrow + lane;
    f32x4 v[8]; float s = 0.f;
#pragma unroll
    for (int j = 0; j < 8; ++j) { v[j] = xr[64 * j]; s += (v[j].x * v[j].x + v[j].y * v[j].y) + (v[j].z * v[j].z + v[j].w * v[j].w); }
    const float r = rsqrtf(wave_sum(s) * (1.f / DM) + EPS);
    const GAS f32x4* gr = (const GAS f32x4*)g + lane;
#pragma unroll
    for (int j = 0; j < 8; ++j) { const f32x4 gv = gr[64 * j]; xr[64 * j] = v[j] * r * gv; }
}
__device__ __forceinline__ const float* x_src_row(const float* xp, const float* xs, const float* out, int layer, int tok) {
    if (layer > 0) return out + (size_t)tok * DM;
    return tok < 2 * SEQ ? xp + (size_t)tok * DM : xs + (size_t)(tok - 2 * SEQ) * DM;
}
__device__ __forceinline__ void p_prologue(const Frame& F0) {
    Frame F = F0; F.lane = lane_id_fresh(); F.tid = F.wave * 64 + F.lane;
    const float *memp = FIN(2), *mems = FIN(3), *w_in_a = FIN(4), *w_in_b = FIN(5), *w_kv = FIN(6), *w_out = FIN(7), *mem_norm_g = FIN(9), *lb_logits = FIN(10);
    float* lbvec = FWS(float, WS_LBVEC); bf16 *WINA = FWS(bf16, WS_WINA), *WINB = FWS(bf16, WS_WINB), *WOUT = FWS(bf16, WS_WOUT), *WKV = FWS(bf16, WS_WKV), *MEMH = FWS(bf16, WS_MEMH);
    LAS float* scr = (LAS float*)(F.lds + RING_OFF + F.wave * 16384);
    const int gw = blockIdx.x * NWAVES + F.wave, NGW = F.G * NWAVES;
    constexpr int I_A = (DM / 64) * (P_A / 32), I_B = (DM / 64) * (P_B / 32), I_O = (MIXW / 64) * (DM / 32), I_K = (DM / 64) * (2048 / 32);
    constexpr int NITEMS = 2 * I_A + 2 * I_B + 4 * I_O + 4 * I_K;
    for (int it = gw; it < NITEMS; it += NGW) {
        int r = it;
        if (r < 2 * I_A) { const int a = r / I_A; p0_transpose_item(w_in_a + (size_t)a * DM * P_A, DM, P_A, WINA + (size_t)a * P_A * DM, scr, r % I_A, F.lane); continue; } r -= 2 * I_A;
        if (r < 2 * I_B) { const int a = r / I_B; p0_transpose_item(w_in_b + (size_t)a * DM * P_B, DM, P_B, WINB + (size_t)a * P_B * DM, scr, r % I_B, F.lane); continue; } r -= 2 * I_B;
        if (r < 4 * I_O) { const int a = r / I_O; p0_transpose_item(w_out + (size_t)a * MIXW * DM, MIXW, DM, WOUT + (size_t)a * DM * MIXW, scr, r % I_O, F.lane); continue; } r -= 4 * I_O;
        { const int a = r / I_K; p0_transpose_item(w_kv + (size_t)a * DM * 2048, DM, 2048, WKV + (size_t)a * 2048 * DM, scr, r % I_K, F.lane); }
    }
    for (int i = (blockIdx.x * NWAVES + F.wave) * 64 + F.lane; i < 2 * 6144; i += NGW * 64) {
        float v = 0.f;
        if (i >= 6144) { const int c = i - 6144; const float l0 = lb_logits[c], l1 = lb_logits[6144 + c]; v = 1.0f / (1.0f + expf(l0 - l1)); }
        lbvec[i] = v;
    }
    for (int it = gw; it < NLAYER * 2560; it += NGW) { const int i = it / 2560, m = it % 2560;
        const float* src = m < 512 ? memp + (size_t)m * DM : mems + (size_t)(m - 512) * DM;
        rms_row_bf16(src, mem_norm_g + i * DM, MEMH + (size_t)it * DM, F.lane); }
}
__device__ __forceinline__ void p_norm(const Frame& F0, int layer, int g, int wg0) {
    Frame F = F0; F.lane = lane_id_fresh(); F.tid = F.wave * 64 + F.lane;
    const float *xp = FIN(0), *xs = FIN(1), *norm_g = FIN(8); const float* out = FOUT(); bf16* H = FWS(bf16, WS_H);
    if ((int)blockIdx.x < wg0) return;
    const int gw = ((int)blockIdx.x - wg0) * NWAVES + F.wave, NGW = (F.G - wg0) * NWAVES;
    for (int t = gw; t < GT; t += NGW) rms_row_bf16(x_src_row(xp, xs, out, layer, g * GT + t), norm_g + layer * DM, H + (size_t)t * DM, F.lane);
}
__device__ __forceinline__ void p_final(const Frame& F0) {
    Frame F = F0; F.lane = lane_id_fresh(); F.tid = F.wave * 64 + F.lane;
    const float* final_g = FIN(13); float* out = FOUT();
    const int gw = blockIdx.x * NWAVES + F.wave, NGW = F.G * NWAVES;
    for (int t = gw; t < NTOK; t += NGW) rms_row_f32_inplace(out + (size_t)t * DM, final_g, F.lane);
}

#ifndef USE_SCAN_OPT
#define USE_SCAN_OPT 1
#endif
#ifndef USE_ATTN_OPT
#define USE_ATTN_OPT 1
#endif
__device__ __forceinline__ void scan_naive(Frame& F, int u) {
    const bf16* PROJ = FWS(bf16, WS_PROJ); float* OPART = FWS(float, WS_OPART);
    const int dir = u / 48, sl = (u % 48) / 24, head = u % 24;
    LAS float* qs_l = (LAS float*)(F.lds + RING_OFF);
    LAS float* f_l = qs_l + 4096; LAS float* k_l = f_l + 4096; LAS float* v_l = k_l + 4096; LAS float* op_l = v_l + 4096;
    const int tid = F.tid, v = tid & 127, dg = tid >> 7, lr = tid >> 4, lc = (tid & 15) * 8;
    const bf16* proj = PROJ + (size_t)(sl * SEQ) * P_A;
    float* opart = OPART + ((size_t)dir * GT + sl * SEQ) * TOKW + head * HD;
    float S[32];
#pragma unroll
    for (int i = 0; i < 32; ++i) S[i] = 0.f;
    for (int c = 0; c < SEQ / 32; ++c) {
        const int idx = 32 * c + lr, t = dir ? (SEQ - 1 - idx) : idx;
        { const bf16* row = proj + (size_t)t * P_A;
          const bf16x8 q8 = *(const GAS bf16x8*)(row + head * HD + lc);
          const bf16x8 g8 = *(const GAS bf16x8*)(row + TOKW + dir * TOKW + head * HD + lc);
          const bf16x8 v8 = *(const GAS bf16x8*)(row + 3 * TOKW + head * HD + lc);
#pragma unroll
          for (int j = 0; j < 8; ++j) { const int o = lr * 128 + lc + j; const float ff = __expf(bf2f((unsigned short)g8[j]));
              qs_l[o] = bf2f((unsigned short)q8[j]); f_l[o] = ff; k_l[o] = 1.0f - ff; v_l[o] = bf2f((unsigned short)v8[j]); } }
        __syncthreads();
        for (int r = 0; r < 32; ++r) {
            const float vv = v_l[r * 128 + v]; float acc = 0.f;
            const LAS f32x4* fp = (const LAS f32x4*)(f_l + r * 128 + dg * 32); const LAS f32x4* kp = (const LAS f32x4*)(k_l + r * 128 + dg * 32); const LAS f32x4* qp = (const LAS f32x4*)(qs_l + r * 128 + dg * 32);
#pragma unroll
            for (int i4 = 0; i4 < 8; ++i4) { const f32x4 f4 = fp[i4], k4 = kp[i4], q4 = qp[i4];
#pragma unroll
                for (int j = 0; j < 4; ++j) { S[i4 * 4 + j] = f4[j] * S[i4 * 4 + j] + k4[j] * vv; acc += S[i4 * 4 + j] * q4[j]; } }
            op_l[(r * 4 + dg) * 128 + v] = acc;
        }
        __syncthreads();
        { f32x4 o0, o1;
#pragma unroll
          for (int j = 0; j < 4; ++j) { o0[j] = (op_l[(lr * 4 + 0) * 128 + lc + j] + op_l[(lr * 4 + 1) * 128 + lc + j]) + (op_l[(lr * 4 + 2) * 128 + lc + j] + op_l[(lr * 4 + 3) * 128 + lc + j]);
              o1[j] = (op_l[(lr * 4 + 0) * 128 + lc + 4 + j] + op_l[(lr * 4 + 1) * 128 + lc + 4 + j]) + (op_l[(lr * 4 + 2) * 128 + lc + 4 + j] + op_l[(lr * 4 + 3) * 128 + lc + 4 + j]); }
          GAS f32x4* op = (GAS f32x4*)(opart + (size_t)t * TOKW + lc); op[0] = o0; op[1] = o1; }
        __syncthreads();
    }
}
constexpr int SC_QM = 0, SC_KM = 8192, SC_QE = 16384, SC_KT = 24576, SC_VT = 34816, SC_EL = 45056, SC_DIR = 46080, SC_RS = 80;
typedef float f32x16 __attribute__((ext_vector_type(16)));
typedef float f32x2v __attribute__((ext_vector_type(2)));
typedef unsigned long long u64;
__device__ __forceinline__ float ex2(float x) { return __builtin_amdgcn_exp2f(x); }
__device__ __forceinline__ bf16x8 mk8(unsigned a, unsigned b, unsigned c, unsigned d) { v4u w = {a, b, c, d}; return __builtin_bit_cast(bf16x8, w); }
__device__ __forceinline__ bf16x8 mk8q(u64 lo, u64 hi) { v4u w = {(unsigned)lo, (unsigned)(lo >> 32), (unsigned)hi, (unsigned)(hi >> 32)}; return __builtin_bit_cast(bf16x8, w); }
__device__ __forceinline__ f32x2v bf2(unsigned w) { return (f32x2v){bflo(w), bfhi(w)}; }
__device__ __forceinline__ void scan_P(LAS unsigned char* L, const unsigned (&q2)[8], const unsigned (&g2)[8], const unsigned (&v2)[8], int cp, int rgp, int l15) {
    constexpr float LOG2E = 1.4426950408889634f;
    f32x2v G[8], f[8]; f32x2v s = {0.f, 0.f};
#pragma unroll
    for (int i = 0; i < 8; ++i) { G[i] = bf2(g2[i]) * LOG2E; s += G[i]; f[i].x = ex2(G[i].x); f[i].y = ex2(G[i].y); }
    const float Ta0 = __shfl(s.x, l15), Ta1 = __shfl(s.x, l15 + 16), Ta2 = __shfl(s.x, l15 + 32), Ta3 = __shfl(s.x, l15 + 48);
    const float Tb0 = __shfl(s.y, l15), Tb1 = __shfl(s.y, l15 + 16), Tb2 = __shfl(s.y, l15 + 32), Tb3 = __shfl(s.y, l15 + 48);
    const f32x2v c15 = {Ta0 + Ta1, Tb0 + Tb1}, c31 = {c15.x + Ta2 + Ta3, c15.y + Tb2 + Tb3};
    f32x2v r0 = {(rgp > 0 ? Ta0 : 0.f) + (rgp > 1 ? Ta1 : 0.f) + (rgp > 2 ? Ta2 : 0.f), (rgp > 0 ? Tb0 : 0.f) + (rgp > 1 ? Tb1 : 0.f) + (rgp > 2 ? Tb2 : 0.f)};
    r0 -= c15;
    f32x2v e = {ex2(fminf(fmaxf(r0.x, -100.f), 100.f)), ex2(fminf(fmaxf(r0.y, -100.f), 100.f))};
    const f32x2v E15 = {ex2(c15.x), ex2(c15.y)}, Dd = {ex2(c31.x - c15.x), ex2(c31.y - c15.y)};
    unsigned kta[4], ktb[4], vta[4], vtb[4];
#pragma unroll
    for (int j = 0; j < 4; ++j) { f32x2v ke[2];
#pragma unroll
        for (int t = 0; t < 2; ++t) { const int i = 2 * j + t; const int row = 8 * rgp + i;
            e = e * f[i]; e.x = fmaxf(e.x, 1e-30f); e.y = fmaxf(e.y, 1e-30f);
            const f32x2v ek = {__builtin_amdgcn_rcpf(e.x), __builtin_amdgcn_rcpf(e.y)};
            const f32x2v qm = bf2(q2[i]) * e, km = (1.0f - f[i]) * ek, qe = qm * E15;
            const int off = row * 256 + ((4 * cp) ^ ((row & 15) << 4));
            *(LAS unsigned*)(L + SC_QM + off) = pg8::cvt_pk_bf16(qm.x, qm.y);
            *(LAS unsigned*)(L + SC_KM + off) = pg8::cvt_pk_bf16(km.x, km.y);
            *(LAS unsigned*)(L + SC_QE + off) = pg8::cvt_pk_bf16(qe.x, qe.y);
            ke[t] = km * Dd; }
        kta[j] = pg8::cvt_pk_bf16(ke[0].x, ke[1].x); ktb[j] = pg8::cvt_pk_bf16(ke[0].y, ke[1].y);
        vta[j] = (v2[2 * j] & 0xffffu) | (v2[2 * j + 1] << 16); vtb[j] = (v2[2 * j] >> 16) | (v2[2 * j + 1] & 0xffff0000u); }
    *(LAS v4u*)(L + SC_KT + (2 * cp) * SC_RS + 16 * rgp) = (v4u){kta[0], kta[1], kta[2], kta[3]};
    *(LAS v4u*)(L + SC_KT + (2 * cp + 1) * SC_RS + 16 * rgp) = (v4u){ktb[0], ktb[1], ktb[2], ktb[3]};
    *(LAS v4u*)(L + SC_VT + (2 * cp) * SC_RS + 16 * rgp) = (v4u){vta[0], vta[1], vta[2], vta[3]};
    *(LAS v4u*)(L + SC_VT + (2 * cp + 1) * SC_RS + 16 * rgp) = (v4u){vtb[0], vtb[1], vtb[2], vtb[3]};
    if (rgp == 0) *(LAS f32x2v*)(L + SC_EL + 8 * cp) = (f32x2v){ex2(c31.x), ex2(c31.y)};
}
__device__ __forceinline__ void scan_M(const LAS unsigned char* L, LAS unsigned char* ot_lds, f32x16 (&S)[4], int w, int n, int h, bf16* op, long ostep) {
    f32x16 X;
#pragma unroll
    for (int r = 0; r < 16; ++r) X[r] = 0.f;
#pragma unroll
    for (int ks = 0; ks < 8; ++ks) { const int off = n * 256 + ((32 * ks + 16 * h) ^ ((n & 15) << 4));
        const bf16x8 a = *(const LAS bf16x8*)(L + SC_KM + off), b = *(const LAS bf16x8*)(L + SC_QM + off);
        X = __builtin_amdgcn_mfma_f32_32x32x16_bf16(a, b, X, 0, 0, 0); }
#pragma unroll
    for (int r = 0; r < 16; ++r) { const int s = (r & 3) + 8 * (r >> 2) + 4 * h; X[r] = (s <= n) ? X[r] : 0.f; }
    f32x16 o;
#pragma unroll
    for (int r = 0; r < 16; ++r) o[r] = 0.f;
    const int vrow = (32 * w + n) * SC_RS;
#pragma unroll
    for (int st = 0; st < 2; ++st) {
        const bf16x8 xa = mk8(pg8::cvt_pk_bf16(X[8 * st + 0], X[8 * st + 1]), pg8::cvt_pk_bf16(X[8 * st + 2], X[8 * st + 3]), pg8::cvt_pk_bf16(X[8 * st + 4], X[8 * st + 5]), pg8::cvt_pk_bf16(X[8 * st + 6], X[8 * st + 7]));
        const u64 lo = *(const LAS u64*)(L + SC_VT + vrow + 32 * st + 8 * h), hi = *(const LAS u64*)(L + SC_VT + vrow + 32 * st + 8 * h + 16);
        o = __builtin_amdgcn_mfma_f32_32x32x16_bf16(xa, mk8q(lo, hi), o, 0, 0, 0); }
#pragma unroll
    for (int i = 0; i < 4; ++i)
#pragma unroll
        for (int st = 0; st < 2; ++st) { const int cb0 = 64 * i + 32 * st + 8 * h, sw = (n & 15) << 4;
            const u64 lo = *(const LAS u64*)(L + SC_QE + n * 256 + (cb0 ^ sw)), hi = *(const LAS u64*)(L + SC_QE + n * 256 + ((cb0 + 16) ^ sw));
            const bf16x8 sb = mk8(pg8::cvt_pk_bf16(S[i][8 * st + 0], S[i][8 * st + 1]), pg8::cvt_pk_bf16(S[i][8 * st + 2], S[i][8 * st + 3]), pg8::cvt_pk_bf16(S[i][8 * st + 4], S[i][8 * st + 5]), pg8::cvt_pk_bf16(S[i][8 * st + 6], S[i][8 * st + 7]));
            o = __builtin_amdgcn_mfma_f32_32x32x16_bf16(mk8q(lo, hi), sb, o, 0, 0, 0); }
#pragma unroll
    for (int i = 0; i < 4; ++i) {
#pragma unroll
        for (int q = 0; q < 4; ++q) { const f32x4 el = *(const LAS f32x4*)(L + SC_EL + 4 * (32 * i + 8 * q + 4 * h));
#pragma unroll
            for (int j = 0; j < 4; ++j) S[i][4 * q + j] *= el[j]; }
#pragma unroll
        for (int st = 0; st < 2; ++st) { const bf16x8 a = *(const LAS bf16x8*)(L + SC_KT + (32 * i + n) * SC_RS + 32 * st + 16 * h), b = *(const LAS bf16x8*)(L + SC_VT + vrow + 32 * st + 16 * h);
            S[i] = __builtin_amdgcn_mfma_f32_32x32x16_bf16(a, b, S[i], 0, 0, 0); } }
    LAS float* ot = (LAS float*)(ot_lds);
#pragma unroll
    for (int r = 0; r < 16; ++r) ot[((r & 3) + 8 * (r >> 2) + 4 * h) * 33 + n] = o[r];
    asm volatile("s_waitcnt lgkmcnt(0)" ::: "memory");
    { const int lane = 32 * h + n, row = lane >> 1, c0 = (lane & 1) * 16; const LAS float* src = ot + row * 33 + c0;
      v4u w0, w1;
      w0.x = pg8::cvt_pk_bf16(src[0], src[1]); w0.y = pg8::cvt_pk_bf16(src[2], src[3]); w0.z = pg8::cvt_pk_bf16(src[4], src[5]); w0.w = pg8::cvt_pk_bf16(src[6], src[7]);
      w1.x = pg8::cvt_pk_bf16(src[8], src[9]); w1.y = pg8::cvt_pk_bf16(src[10], src[11]); w1.z = pg8::cvt_pk_bf16(src[12], src[13]); w1.w = pg8::cvt_pk_bf16(src[14], src[15]);
      bf16* dst = op + (long)row * ostep + c0; *(GAS v4u*)dst = w0; *(GAS v4u*)(dst + 8) = w1; }
    asm volatile("s_waitcnt lgkmcnt(0)" ::: "memory");
}
__device__ __forceinline__ void scan_opt(const Frame& F, const bf16* PROJ, bf16* OPART, int u) {
    constexpr int NCH = SEQ / 32;
    const int dir = u / 48, sl = (u % 48) / NHEAD, head = u % NHEAD;
    const int lane = F.lane, W = F.wave, w = W & 3;
    LAS unsigned char* L0 = F.lds + RING_OFF;
    if (W >= 4) {
        const int cp = 16 * w + (lane & 15), rgp = lane >> 4, l15 = lane & 15;
        const GAS char* bq = (const GAS char*)(PROJ + (size_t)(sl * SEQ) * P_A + head * HD);
        const GAS char* bg = bq + (size_t)(TOKW + dir * TOKW) * 2; const GAS char* bv = bq + (size_t)(3 * TOKW) * 2;
        const int rstep = dir ? -(P_A * 2) : (P_A * 2);
        unsigned voff = (unsigned)((dir ? (SEQ - 1 - 8 * rgp) : (8 * rgp)) * (P_A * 2) + 4 * cp);
        const int cstep = 32 * rstep;
        unsigned qA[8], gA[8], vA[8], qB[8], gB[8], vB[8], qC[8], gC[8], vC[8];
#define SC_LOAD(Q_, G_, V_) do { _Pragma("unroll") for (int i = 0; i < 8; ++i) { const unsigned o_ = voff + (unsigned)(i * rstep); \
        Q_[i] = *(const GAS unsigned*)(bq + o_); G_[i] = *(const GAS unsigned*)(bg + o_); V_[i] = *(const GAS unsigned*)(bv + o_); } voff += (unsigned)cstep; } while (0)
#define SC_STEP(c_, QL, GL, VL, QP, GP, VP, BUF_) do { if ((c_) + 3 < NCH) SC_LOAD(QL, GL, VL); if ((c_) + 1 < NCH) scan_P(L0 + (BUF_) * SC_DIR, QP, GP, VP, cp, rgp, l15); __syncthreads(); } while (0)
        SC_LOAD(qA, gA, vA); SC_LOAD(qB, gB, vB); SC_LOAD(qC, gC, vC);
        scan_P(L0, qA, gA, vA, cp, rgp, l15);
        __syncthreads();
        int c = 0;
        for (; c + 6 <= NCH; c += 6) {
            SC_STEP(c + 0, qA, gA, vA, qB, gB, vB, 1);
            SC_STEP(c + 1, qB, gB, vB, qC, gC, vC, 0);
            SC_STEP(c + 2, qC, gC, vC, qA, gA, vA, 1);
            SC_STEP(c + 3, qA, gA, vA, qB, gB, vB, 0);
            SC_STEP(c + 4, qB, gB, vB, qC, gC, vC, 1);
            SC_STEP(c + 5, qC, gC, vC, qA, gA, vA, 0);
        }
        SC_STEP(c + 0, qA, gA, vA, qB, gB, vB, 1);
        SC_STEP(c + 1, qB, gB, vB, qC, gC, vC, 0);
        static_assert(NCH % 6 == 2, "tail of the producer loop is written for NCH = 6k + 2");
#undef SC_STEP
#undef SC_LOAD
    } else {
        const int n = lane & 31, h = lane >> 5;
        f32x16 S[4];
#pragma unroll
        for (int i = 0; i < 4; ++i)
#pragma unroll
            for (int r = 0; r < 16; ++r) S[i][r] = 0.f;
        const long ostep = dir ? -(long)TOKW : (long)TOKW;
        bf16* op = OPART + ((size_t)dir * GT + sl * SEQ + (dir ? SEQ - 1 : 0)) * TOKW + head * HD + 32 * w;
        LAS unsigned char* otl = L0 + 2 * SC_DIR + w * 4352;
        __syncthreads();
        for (int c = 0; c < NCH; c += 2) {
            scan_M(L0, otl, S, w, n, h, op, ostep); op += 32 * ostep;
            __syncthreads();
            scan_M(L0 + SC_DIR, otl, S, w, n, h, op, ostep); op += 32 * ostep;
            __syncthreads();
        }
    }
}
__device__ __forceinline__ void combine_naive(const Frame& F0, int a, int item) {
    Frame F = F0; F.lane = lane_id_fresh(); F.tid = F.wave * 64 + F.lane;
    const bf16* PROJ = FWS(bf16, WS_PROJ); const bf16* OPART = FWS(bf16, WS_OPART); bf16* OG = OGBUF(item); const float* onorm_g = FIN(11) + a * TOKW;
    const int gw = blockIdx.x * NWAVES + F.wave, NGW = F.G * NWAVES, lane = F.lane;
    f32x4 gv[12];
    { const GAS f32x4* gn = (const GAS f32x4*)onorm_g + lane;
#pragma unroll
      for (int hp = 0; hp < 12; ++hp) gv[hp] = gn[64 * hp]; }
    for (int tau = gw; tau < GT; tau += NGW) {
        const GAS u64* p0 = (const GAS u64*)(OPART + (size_t)tau * TOKW) + lane; const GAS u64* p1 = (const GAS u64*)(OPART + ((size_t)GT + tau) * TOKW) + lane;
        const GAS u64* sg = (const GAS u64*)(PROJ + (size_t)tau * P_A + GATE_A) + lane;
        GAS u64* og = (GAS u64*)(OG + (size_t)tau * MIXW) + lane;
        u64 a0[12], a1[12], sv[12];
#pragma unroll
        for (int hp = 0; hp < 12; ++hp) { a0[hp] = p0[64 * hp]; a1[hp] = p1[64 * hp]; sv[hp] = sg[64 * hp]; }
#pragma unroll
        for (int hp = 0; hp < 12; ++hp) {
            const f32x4 o = {bflo((unsigned)a0[hp]) + bflo((unsigned)a1[hp]), bfhi((unsigned)a0[hp]) + bfhi((unsigned)a1[hp]), bflo((unsigned)(a0[hp] >> 32)) + bflo((unsigned)(a1[hp] >> 32)), bfhi((unsigned)(a0[hp] >> 32)) + bfhi((unsigned)(a1[hp] >> 32))};
            float ss = (o.x * o.x + o.y * o.y) + (o.z * o.z + o.w * o.w);
#pragma unroll
            for (int m = 1; m < 32; m <<= 1) ss += __shfl_xor(ss, m);
            const float rs = rsqrtf(ss * (1.0f / HD) + EPS); const u64 s = sv[hp];
            const unsigned lo = pg8::cvt_pk_bf16(o.x * rs * gv[hp].x * bflo((unsigned)s), o.y * rs * gv[hp].y * bfhi((unsigned)s));
            const unsigned hi = pg8::cvt_pk_bf16(o.z * rs * gv[hp].z * bflo((unsigned)(s >> 32)), o.w * rs * gv[hp].w * bfhi((unsigned)(s >> 32)));
            og[64 * hp] = (u64)lo | ((u64)hi << 32); }
    }
}
__device__ __forceinline__ void na_naive_item(Frame& F, const bf16* PROJ, bf16* OG, const float* rpb, int bi, int tau, int head) {
    const int lane = F.lane; LAS float* qsh = (LAS float*)(F.lds + RING_OFF) + F.wave * 512; LAS float* psh = qsh + 256;
    const int sl = tau >> 12, t = tau & 4095, r = t >> 6, c = t & 63;
    const int rs = min(max(r - 4, 0), 56), cs = min(max(c - 8, 0), 48);
    { const unsigned w = *(const GAS unsigned*)(PROJ + (size_t)tau * P_B + head * HD + 2 * lane); qsh[2 * lane] = bflo(w); qsh[2 * lane + 1] = bfhi(w); }
    LDS_WAIT(); asm volatile("" ::: "memory");
    float s[2];
#pragma unroll
    for (int jj = 0; jj < 2; ++jj) { const int n = lane + 64 * jj, j = n >> 4, i = n & 15; const int ktok = sl * SEQ + (rs + j) * 64 + cs + i;
        const bf16* krow = PROJ + (size_t)ktok * P_B + TOKW + head * HD; float dot = 0.f;
        for (int d8 = 0; d8 < 16; ++d8) { const bf16x8 k8 = *(const GAS bf16x8*)(krow + d8 * 8); const f32x4 qa = *(const LAS f32x4*)(qsh + d8 * 8), qb = *(const LAS f32x4*)(qsh + d8 * 8 + 4);
#pragma unroll
            for (int e = 0; e < 4; ++e) { dot += qa[e] * bf2f((unsigned short)k8[e]); dot += qb[e] * bf2f((unsigned short)k8[4 + e]); } }
        s[jj] = dot + rpb[((size_t)(bi * NHEAD + head) * 15 + (rs + j - r + 7)) * 31 + (cs + i - c + 15)]; }
    const float m = wave_max(fmaxf(s[0], s[1])); const float e0 = __expf(s[0] - m), e1 = __expf(s[1] - m); const float inv = 1.0f / wave_sum(e0 + e1);
    psh[lane] = e0 * inv; psh[lane + 64] = e1 * inv;
    LDS_WAIT(); asm volatile("" ::: "memory");
    float a0 = 0.f, a1 = 0.f;
    for (int n = 0; n < 128; ++n) { const int j = n >> 4, i = n & 15; const int ktok = sl * SEQ + (rs + j) * 64 + cs + i;
        const unsigned w = *(const GAS unsigned*)(PROJ + (size_t)ktok * P_B + 2 * TOKW + head * HD + 2 * lane); const float p = psh[n]; a0 += p * bflo(w); a1 += p * bfhi(w); }
    const unsigned sg = *(const GAS unsigned*)(PROJ + (size_t)tau * P_B + GATE_B + head * HD + 2 * lane);
    *(GAS unsigned*)(OG + (size_t)tau * MIXW + head * HD + 2 * lane) = pg8::cvt_pk_bf16(a0 * bflo(sg), a1 * bfhi(sg));
    LDS_WAIT(); asm volatile("" ::: "memory");
}
__device__ __forceinline__ void mem_naive_item(Frame& F, const bf16* PROJ, bf16* OG, const bf16* KV, int layer, int g, int tau, int mh) {
    const int lane = F.lane; LAS float* qsh = (LAS float*)(F.lds + RING_OFF) + F.wave * 512; LAS float* psh = qsh + 256;
    const int P = (layer & 1) ? P_B : P_A, QM = (layer & 1) ? QM_B : QM_A, GATE = (layer & 1) ? GATE_B : GATE_A;
    const int seq = g * 2 + (tau >> 12);
    const bf16* kv = KV + ((size_t)layer * 2560 + seq * NMEM) * 2048;
    { const unsigned long long w = *(const GAS unsigned long long*)(PROJ + (size_t)tau * P + QM + mh * MHD + 4 * lane);
      qsh[4 * lane] = bflo((unsigned)w); qsh[4 * lane + 1] = bfhi((unsigned)w); qsh[4 * lane + 2] = bflo((unsigned)(w >> 32)); qsh[4 * lane + 3] = bfhi((unsigned)(w >> 32)); }
    LDS_WAIT(); asm volatile("" ::: "memory");
    float s[4];
#pragma unroll
    for (int jj = 0; jj < 4; ++jj) { const int m = lane + 64 * jj; const bf16* krow = kv + (size_t)m * 2048 + mh * MHD; float dot = 0.f;
        for (int d8 = 0; d8 < 32; ++d8) { const bf16x8 k8 = *(const GAS bf16x8*)(krow + d8 * 8); const f32x4 qa = *(const LAS f32x4*)(qsh + d8 * 8), qb = *(const LAS f32x4*)(qsh + d8 * 8 + 4);
#pragma unroll
            for (int e = 0; e < 4; ++e) { dot += qa[e] * bf2f((unsigned short)k8[e]); dot += qb[e] * bf2f((unsigned short)k8[4 + e]); } }
        s[jj] = dot; }
    const float mx = wave_max(fmaxf(fmaxf(s[0], s[1]), fmaxf(s[2], s[3])));
    float e[4]; float es = 0.f;
#pragma unroll
    for (int jj = 0; jj < 4; ++jj) { e[jj] = __expf(s[jj] - mx); es += e[jj]; }
    const float inv = 1.0f / wave_sum(es);
#pragma unroll
    for (int jj = 0; jj < 4; ++jj) psh[lane + 64 * jj] = e[jj] * inv;
    LDS_WAIT(); asm volatile("" ::: "memory");
    float a0 = 0.f, a1 = 0.f, a2 = 0.f, a3 = 0.f;
    for (int m = 0; m < NMEM; ++m) { const unsigned long long w = *(const GAS unsigned long long*)(kv + (size_t)m * 2048 + MEMW + mh * MHD + 4 * lane); const float p = psh[m];
        a0 += p * bflo((unsigned)w); a1 += p * bfhi((unsigned)w); a2 += p * bflo((unsigned)(w >> 32)); a3 += p * bfhi((unsigned)(w >> 32)); }
    const unsigned long long sg = *(const GAS unsigned long long*)(PROJ + (size_t)tau * P + GATE + TOKW + mh * MHD + 4 * lane);
    const unsigned lo = pg8::cvt_pk_bf16(a0 * bflo((unsigned)sg), a1 * bfhi((unsigned)sg)), hi = pg8::cvt_pk_bf16(a2 * bflo((unsigned)(sg >> 32)), a3 * bfhi((unsigned)(sg >> 32)));
    *(GAS unsigned long long*)(OG + (size_t)tau * MIXW + TOKW + mh * MHD + 4 * lane) = (unsigned long long)lo | ((unsigned long long)hi << 32);
    LDS_WAIT(); asm volatile("" ::: "memory");
}
typedef short s16x4 __attribute__((ext_vector_type(4)));
constexpr int AT_K = 0, AT_V = 32768, AT_B = 49152;
__device__ __forceinline__ int v_st_plain(int k, int c) { return ((k >> 3) * 4 + (c >> 5)) * 512 + ((k & 7) * 32 + (c & 31)) * 2; }
__device__ __forceinline__ int v_rd_base(int lane) { return ((lane & 3) << 3) | (((lane >> 2) & 3) << 6) | (((lane >> 4) & 1) << 5) | (((lane >> 5) & 1) << 8); }
constexpr int v_rd_off(int d0, int ks, int half) { return d0 * 512 + ks * 4096 + half * 2048; }
template <int OFF> __device__ __forceinline__ s16x4 tr_read(int vb) { s16x4 r; asm volatile("ds_read_b64_tr_b16 %0, %1 offset:%2" : "=&v"(r) : "v"(vb), "i"(OFF) : "memory"); return r; }
template <int D0> __device__ __forceinline__ void pv_one(f32x16& od, int vb, bf16x8 b0, bf16x8 b1, bf16x8 b2, bf16x8 b3) {
    const s16x4 l0 = tr_read<v_rd_off(D0, 0, 0)>(vb), h0 = tr_read<v_rd_off(D0, 0, 1)>(vb), l1 = tr_read<v_rd_off(D0, 1, 0)>(vb), h1 = tr_read<v_rd_off(D0, 1, 1)>(vb);
    const s16x4 l2 = tr_read<v_rd_off(D0, 2, 0)>(vb), h2 = tr_read<v_rd_off(D0, 2, 1)>(vb), l3 = tr_read<v_rd_off(D0, 3, 0)>(vb), h3 = tr_read<v_rd_off(D0, 3, 1)>(vb);
    asm volatile("s_waitcnt lgkmcnt(0)" ::: "memory"); __builtin_amdgcn_sched_barrier(0);
#define AT_PK(L_, H_) (bf16x8){L_[0], L_[1], L_[2], L_[3], H_[0], H_[1], H_[2], H_[3]}
    od = __builtin_amdgcn_mfma_f32_32x32x16_bf16(AT_PK(l0, h0), b0, od, 0, 0, 0);
    od = __builtin_amdgcn_mfma_f32_32x32x16_bf16(AT_PK(l1, h1), b1, od, 0, 0, 0);
    od = __builtin_amdgcn_mfma_f32_32x32x16_bf16(AT_PK(l2, h2), b2, od, 0, 0, 0);
    od = __builtin_amdgcn_mfma_f32_32x32x16_bf16(AT_PK(l3, h3), b3, od, 0, 0, 0);
#undef AT_PK
}
template <int NQK, bool NA>
__device__ __forceinline__ void attn_item(const Frame& F, const bf16* qp, const bf16* kv, int rstride, int kcol, int vcol, int tlo, int thi, int alo, int ahi, int qcol, int cs, int rq, bf16* og, const bf16* sg) {
    constexpr int ROWB = NQK * 32, KP = NQK / 4; constexpr float LOG2E = 1.4426950408889634f;
    const int tid = F.tid, lane = F.lane, n = lane & 31, h = lane >> 5;
    LAS unsigned char* Kl = F.lds + RING_OFF + AT_K; LAS unsigned char* Vl = F.lds + RING_OFF + AT_V; const LAS float* Bl = (const LAS float*)(F.lds + RING_OFF + AT_B);
    constexpr bool QREG = (NQK <= 8);
    bf16x8 qr[QREG ? NQK : 1];
    if (QREG) {
#pragma unroll
        for (int d0 = 0; d0 < NQK; ++d0) qr[d0] = *(const GAS bf16x8*)(qp + 16 * d0); }
    f32x16 o[4];
#pragma unroll
    for (int d = 0; d < 4; ++d)
#pragma unroll
        for (int r = 0; r < 16; ++r) o[d][r] = 0.f;
    float m = -1e30f, l = 0.f;
    bf16x8 ks_[KP], vs_[2];
    int krow[KP], kch[KP];
#pragma unroll
    for (int i = 0; i < KP; ++i) { const int p = tid + 512 * i; krow[i] = p / (NQK * 2); kch[i] = p % (NQK * 2); }
    const int vrow0 = tid >> 4, vc = (tid & 15) * 8;
#define AT_LOAD(t_) do { const bf16* b_ = kv + (size_t)(t_) * 64 * rstride; \
        _Pragma("unroll") for (int i = 0; i < KP; ++i) ks_[i] = *(const GAS bf16x8*)(b_ + (size_t)krow[i] * rstride + kcol + kch[i] * 8); \
        _Pragma("unroll") for (int i = 0; i < 2; ++i) vs_[i] = *(const GAS bf16x8*)(b_ + (size_t)(vrow0 + 32 * i) * rstride + vcol + vc); } while (0)
#define AT_WRITE() do { _Pragma("unroll") for (int i = 0; i < KP; ++i) *(LAS bf16x8*)(Kl + krow[i] * ROWB + ((kch[i] * 16) ^ ((krow[i] & 7) << 4))) = ks_[i]; \
        _Pragma("unroll") for (int i = 0; i < 2; ++i) *(LAS bf16x8*)(Vl + v_st_plain(vrow0 + 32 * i, vc)) = vs_[i]; } while (0)
    const int vb = (int)(size_t)Vl + v_rd_base(lane);
    AT_LOAD(tlo);
    for (int t = tlo; t <= thi; ++t) {
        __syncthreads();
        AT_WRITE();
        if (t < thi) AT_LOAD(t + 1);
        __syncthreads();
        if (t >= alo && t <= ahi) {
            f32x16 p0, p1;
#pragma unroll
            for (int r = 0; r < 16; ++r) { p0[r] = 0.f; p1[r] = 0.f; }
            if (QREG) {
#pragma unroll
                for (int d0 = 0; d0 < NQK; ++d0) { const int cb = (32 * d0 + 16 * h) ^ ((n & 7) << 4);
                    const bf16x8 a0 = *(const LAS bf16x8*)(Kl + n * ROWB + cb), a1 = *(const LAS bf16x8*)(Kl + (32 + n) * ROWB + cb);
                    p0 = __builtin_amdgcn_mfma_f32_32x32x16_bf16(a0, qr[QREG ? d0 : 0], p0, 0, 0, 0);
                    p1 = __builtin_amdgcn_mfma_f32_32x32x16_bf16(a1, qr[QREG ? d0 : 0], p1, 0, 0, 0); }
            } else {
#pragma unroll
                for (int dq = 0; dq < NQK; dq += 4) { bf16x8 qq[4];
#pragma unroll
                    for (int e = 0; e < 4; ++e) qq[e] = *(const GAS bf16x8*)(qp + 16 * (dq + e));
#pragma unroll
                    for (int e = 0; e < 4; ++e) { const int cb = (32 * (dq + e) + 16 * h) ^ ((n & 7) << 4);
                        const bf16x8 a0 = *(const LAS bf16x8*)(Kl + n * ROWB + cb), a1 = *(const LAS bf16x8*)(Kl + (32 + n) * ROWB + cb);
                        p0 = __builtin_amdgcn_mfma_f32_32x32x16_bf16(a0, qq[e], p0, 0, 0, 0);
                        p1 = __builtin_amdgcn_mfma_f32_32x32x16_bf16(a1, qq[e], p1, 0, 0, 0); }
                    asm volatile("" ::: "memory"); }
            }
            if (NA) { const int dr = t - rq + 7; const LAS float* brow = Bl + dr * 32 + (15 - qcol);
#pragma unroll
                for (int r = 0; r < 16; ++r) { const int kc0 = (r & 3) + 8 * (r >> 2) + 4 * h, kc1 = kc0 + 32;
                    const float b0 = brow[kc0], b1 = brow[kc1];
                    p0[r] = (kc0 >= cs && kc0 < cs + 16) ? (p0[r] + b0) * LOG2E : -1e30f;
                    p1[r] = (kc1 >= cs && kc1 < cs + 16) ? (p1[r] + b1) * LOG2E : -1e30f; }
            } else {
#pragma unroll
                for (int r = 0; r < 16; ++r) { p0[r] *= LOG2E; p1[r] *= LOG2E; }
            }
            float pm = p0[0];
#pragma unroll
            for (int r = 1; r < 16; ++r) pm = fmaxf(pm, p0[r]);
#pragma unroll
            for (int r = 0; r < 16; ++r) pm = fmaxf(pm, p1[r]);
            pm = fmaxf(pm, __shfl_xor(pm, 32));
            const float mn = fmaxf(m, pm), alpha = ex2(m - mn); m = mn;
            float ps = 0.f;
#pragma unroll
            for (int r = 0; r < 16; ++r) { p0[r] = ex2(p0[r] - mn); p1[r] = ex2(p1[r] - mn); ps += p0[r] + p1[r]; }
            l = l * alpha + ps;
            if (__any(alpha < 1.0f)) {
#pragma unroll
                for (int d = 0; d < 4; ++d)
#pragma unroll
                    for (int r = 0; r < 16; ++r) o[d][r] *= alpha; }
            const bf16x8 b0 = mk8(pg8::cvt_pk_bf16(p0[0], p0[1]), pg8::cvt_pk_bf16(p0[2], p0[3]), pg8::cvt_pk_bf16(p0[4], p0[5]), pg8::cvt_pk_bf16(p0[6], p0[7]));
            const bf16x8 b1 = mk8(pg8::cvt_pk_bf16(p0[8], p0[9]), pg8::cvt_pk_bf16(p0[10], p0[11]), pg8::cvt_pk_bf16(p0[12], p0[13]), pg8::cvt_pk_bf16(p0[14], p0[15]));
            const bf16x8 b2 = mk8(pg8::cvt_pk_bf16(p1[0], p1[1]), pg8::cvt_pk_bf16(p1[2], p1[3]), pg8::cvt_pk_bf16(p1[4], p1[5]), pg8::cvt_pk_bf16(p1[6], p1[7]));
            const bf16x8 b3 = mk8(pg8::cvt_pk_bf16(p1[8], p1[9]), pg8::cvt_pk_bf16(p1[10], p1[11]), pg8::cvt_pk_bf16(p1[12], p1[13]), pg8::cvt_pk_bf16(p1[14], p1[15]));
            pv_one<0>(o[0], vb, b0, b1, b2, b3); pv_one<1>(o[1], vb, b0, b1, b2, b3); pv_one<2>(o[2], vb, b0, b1, b2, b3); pv_one<3>(o[3], vb, b0, b1, b2, b3);
        }
    }
#undef AT_LOAD
#undef AT_WRITE
    const float linv = 1.0f / (l + __shfl_xor(l, 32));
#pragma unroll
    for (int d = 0; d < 4; ++d)
#pragma unroll
        for (int q4 = 0; q4 < 4; ++q4) { const int vcol0 = 32 * d + 8 * q4 + 4 * h;
            const u64 g = *(const GAS u64*)(sg + vcol0);
            const unsigned lo = pg8::cvt_pk_bf16(o[d][4 * q4 + 0] * linv * bflo((unsigned)g), o[d][4 * q4 + 1] * linv * bfhi((unsigned)g));
            const unsigned hi = pg8::cvt_pk_bf16(o[d][4 * q4 + 2] * linv * bflo((unsigned)(g >> 32)), o[d][4 * q4 + 3] * linv * bfhi((unsigned)(g >> 32)));
            *(GAS u64*)(og + vcol0) = (u64)lo | ((u64)hi << 32); }
}
__device__ __forceinline__ void na_item(const Frame& F, const bf16* PROJ, bf16* OG, const float* rpb, int bi, int sl, int head, int rb) {
    const int W = F.wave, lane = F.lane, n = lane & 31, h = lane >> 5;
    __syncthreads();
    { LAS float* Bl = (LAS float*)(F.lds + RING_OFF + AT_B); const int dr = F.tid >> 5, dc = F.tid & 31;
      if (dr < 15) Bl[dr * 32 + dc] = dc < 31 ? rpb[((size_t)(bi * NHEAD + head) * 15 + dr) * 31 + dc] : 0.f; }
    const int r0 = 4 * rb, rq = r0 + (W >> 1), qcol = 32 * (W & 1) + n;
    const int tlo = min(max(r0 - 4, 0), 56), thi = min(max(r0 + 3 - 4, 0), 56) + 7, alo = min(max(rq - 4, 0), 56), ahi = alo + 7;
    const int cs = min(max(qcol - 8, 0), 48);
    const size_t tok = (size_t)sl * SEQ + rq * 64 + qcol;
    attn_item<8, true>(F, PROJ + tok * P_B + head * HD + 8 * h, PROJ + (size_t)sl * SEQ * P_B, P_B, TOKW + head * HD, 2 * TOKW + head * HD, tlo, thi, alo, ahi, qcol, cs, rq,
                       OG + tok * MIXW + head * HD, PROJ + tok * P_B + GATE_B + head * HD);
}
typedef float f32x4a __attribute__((ext_vector_type(4)));
constexpr int NA2_TILE = 32768, NA2_BUF = 65536, NA2_V = 16384, NA2_BIAS = 131072 + 1024;
__device__ __forceinline__ s16x4 tr_read_rt(int addr, int) { s16x4 r; asm volatile("ds_read_b64_tr_b16 %0, %1" : "=&v"(r) : "v"(addr) : "memory"); return r; }
template <int OFF> __device__ __forceinline__ s16x4 tr_read_o(int vb) { s16x4 r; asm volatile("ds_read_b64_tr_b16 %0, %1 offset:%2" : "=&v"(r) : "v"(vb), "i"(OFF) : "memory"); return r; }
__device__ __forceinline__ void na_item2(const Frame& F, const bf16* PROJ, const bf16* QH, bf16* OG, const float* rpb, int bi, int sl, int head, int rb) {
    constexpr float LOG2E = 1.4426950408889634f;
    const int W = F.wave, lane = F.lane, tid = F.tid, ql = lane & 15, g = lane >> 4;
    LAS unsigned char* L = F.lds + RING_OFF;
    __syncthreads();
    { LAS float* Bl = (LAS float*)(L + NA2_BIAS); const int dr = tid >> 5, dc = tid & 31;
      if (dr < 15) Bl[dr * 32 + dc] = dc < 31 ? rpb[((size_t)(bi * NHEAD + head) * 15 + dr) * 31 + dc] * LOG2E : 0.f; }
    const int r0 = 4 * rb, rq = r0 + (W >> 1), hq = W & 1;
    const int tlo = min(max(r0 - 4, 0), 56), thi = min(max(r0 + 3 - 4, 0), 56) + 7, alo = min(max(rq - 4, 0), 56), ahi = alo + 7;
    bf16x8 qf[2][4]; unsigned vmask[2]; int bidx[2][2], koff[2][2][4], vbase[2][2];
    const bf16* ogp[2]; const bf16* sgp[2];
#pragma unroll
    for (int bq = 0; bq < 2; ++bq) { const int b = 2 * hq + bq, kst = (b == 0) ? 0 : (b == 1) ? 8 : (b == 2) ? 24 : 32, qc = 16 * b + ql, cs = min(max(qc - 8, 0), 48);
        const size_t tok = (size_t)sl * SEQ + rq * 64 + qc;
#pragma unroll
        for (int s = 0; s < 4; ++s) qf[bq][s] = *(const GAS bf16x8*)(QH + ((size_t)head * GT + tok) * HD + 32 * s + 8 * g);
        ogp[bq] = OG + tok * MIXW + head * HD + 4 * g; sgp[bq] = PROJ + tok * P_B + GATE_B + head * HD + 4 * g;
        unsigned vm = 0;
#pragma unroll
        for (int blk = 0; blk < 2; ++blk) { const int kc0 = kst + 16 * blk + 4 * g;
#pragma unroll
            for (int r = 0; r < 4; ++r) vm |= ((kc0 + r >= cs && kc0 + r < cs + 16) ? 1u : 0u) << (4 * blk + r);
            bidx[bq][blk] = NA2_BIAS + 4 * (kc0 - qc + 15);
            const int krow = kst + 16 * blk + ql;
#pragma unroll
            for (int s = 0; s < 4; ++s) koff[bq][blk][s] = krow * 256 + (((4 * s + g) * 16) ^ ((krow & 7) << 4));
            const int kt = (kst >> 3) + 2 * blk + (g >> 1);
            vbase[bq][blk] = NA2_V + kt * 2048 + ((4 * g + (ql >> 2)) & 7) * 32 + 8 * (ql & 3); }
        vmask[bq] = vm; }
    f32x4a o[2][8];
#pragma unroll
    for (int bq = 0; bq < 2; ++bq)
#pragma unroll
        for (int vt = 0; vt < 8; ++vt) o[bq][vt] = (f32x4a){0.f, 0.f, 0.f, 0.f};
    float m[2] = {-1e30f, -1e30f}, l[2] = {0.f, 0.f};
    const int sr = tid >> 4, sc = (tid & 15) * 8;
    const bf16* kvb = QH + ((size_t)(NHEAD + head) * GT + (size_t)sl * SEQ + sr) * HD + sc;
    bf16x8 ks0, ks1, vs0, vs1, ks2, ks3, vs2, vs3;
    const int kw0 = sr * 256 + ((sc * 2) ^ ((sr & 7) << 4)), kw1 = (32 + sr) * 256 + ((sc * 2) ^ ((sr & 7) << 4));
    const int vw0 = NA2_V + (((sr >> 3) * 8 + (sc >> 4)) * 256) + (sr & 7) * 32 + (sc & 15) * 2, vw1 = vw0 + 4 * 2048;
#define NA_LOAD2(t_) do { const bf16* p_ = kvb + (size_t)(t_) * 64 * HD; constexpr size_t VO_ = (size_t)NHEAD * GT * HD; ks0 = *(const GAS bf16x8*)(p_); ks1 = *(const GAS bf16x8*)(p_ + 32 * HD); \
        vs0 = *(const GAS bf16x8*)(p_ + VO_); vs1 = *(const GAS bf16x8*)(p_ + VO_ + 32 * HD); \
        if ((t_) + 1 <= thi) { const bf16* q_ = p_ + 64 * HD; ks2 = *(const GAS bf16x8*)(q_); ks3 = *(const GAS bf16x8*)(q_ + 32 * HD); \
            vs2 = *(const GAS bf16x8*)(q_ + VO_); vs3 = *(const GAS bf16x8*)(q_ + VO_ + 32 * HD); } } while (0)
#define NA_WRITE2(B_) do { LAS unsigned char* d_ = L + (B_) * NA2_BUF; *(LAS bf16x8*)(d_ + kw0) = ks0; *(LAS bf16x8*)(d_ + kw1) = ks1; *(LAS bf16x8*)(d_ + vw0) = vs0; *(LAS bf16x8*)(d_ + vw1) = vs1; \
        *(LAS bf16x8*)(d_ + NA2_TILE + kw0) = ks2; *(LAS bf16x8*)(d_ + NA2_TILE + kw1) = ks3; *(LAS bf16x8*)(d_ + NA2_TILE + vw0) = vs2; *(LAS bf16x8*)(d_ + NA2_TILE + vw1) = vs3; } while (0)
    ks2 = ks3 = vs2 = vs3 = (bf16x8){0, 0, 0, 0, 0, 0, 0, 0};
    NA_LOAD2(tlo); NA_WRITE2(0);
    __syncthreads();
    for (int t = tlo; t <= thi; t += 2) {
        const int cur = ((t - tlo) >> 1) & 1;
        if (t + 2 <= thi) NA_LOAD2(t + 2);
        for (int u = 0; u < 2; ++u) { const int tt = t + u;
        if (tt <= thi && tt >= alo && tt <= ahi) {
            const LAS unsigned char* Lb = L + cur * NA2_BUF + u * NA2_TILE; const int lb = (int)(size_t)Lb; const int dro = (tt - rq + 7) * 128;
#pragma unroll
            for (int bq = 0; bq < 2; ++bq) {
                f32x4a p[2];
#pragma unroll
                for (int blk = 0; blk < 2; ++blk) { const LAS float* bp = (const LAS float*)(L + bidx[bq][blk] + dro);
#pragma unroll
                    for (int r = 0; r < 4; ++r) p[blk][r] = ((vmask[bq] >> (4 * blk + r)) & 1u) ? bp[r] : -1e30f;
#pragma unroll
                    for (int s = 0; s < 4; ++s) { const bf16x8 a = *(const LAS bf16x8*)(Lb + koff[bq][blk][s]);
                        p[blk] = __builtin_amdgcn_mfma_f32_16x16x32_bf16(a, qf[bq][s], p[blk], 0, 0, 0); } }
                float pm = fmaxf(fmaxf(fmaxf(p[0][0], p[0][1]), fmaxf(p[0][2], p[0][3])), fmaxf(fmaxf(p[1][0], p[1][1]), fmaxf(p[1][2], p[1][3])));
                pm = fmaxf(pm, __shfl_xor(pm, 16)); pm = fmaxf(pm, __shfl_xor(pm, 32));
                const float mn = fmaxf(m[bq], pm), alpha = ex2(m[bq] - mn); m[bq] = mn;
                float ps = 0.f;
#pragma unroll
                for (int blk = 0; blk < 2; ++blk)
#pragma unroll
                    for (int r = 0; r < 4; ++r) { p[blk][r] = ex2(p[blk][r] - mn); ps += p[blk][r]; }
                l[bq] = l[bq] * alpha + ps;
                if (__any(alpha < 1.0f)) {
#pragma unroll
                    for (int vt = 0; vt < 8; ++vt) o[bq][vt] *= alpha; }
                const bf16x8 pb = mk8(pg8::cvt_pk_bf16(p[0][0], p[0][1]), pg8::cvt_pk_bf16(p[0][2], p[0][3]), pg8::cvt_pk_bf16(p[1][0], p[1][1]), pg8::cvt_pk_bf16(p[1][2], p[1][3]));
                const int va = lb + vbase[bq][0], vb2 = lb + vbase[bq][1];
                s16x4 x0[8], x1[8];
                x0[0] = tr_read_o<0>(va); x1[0] = tr_read_o<0>(vb2); x0[1] = tr_read_o<256>(va); x1[1] = tr_read_o<256>(vb2); x0[2] = tr_read_o<512>(va); x1[2] = tr_read_o<512>(vb2); x0[3] = tr_read_o<768>(va); x1[3] = tr_read_o<768>(vb2);
                x0[4] = tr_read_o<1024>(va); x1[4] = tr_read_o<1024>(vb2); x0[5] = tr_read_o<1280>(va); x1[5] = tr_read_o<1280>(vb2); x0[6] = tr_read_o<1536>(va); x1[6] = tr_read_o<1536>(vb2); x0[7] = tr_read_o<1792>(va); x1[7] = tr_read_o<1792>(vb2);
                asm volatile("s_waitcnt lgkmcnt(0)" ::: "memory"); __builtin_amdgcn_sched_barrier(0);
#pragma unroll
                for (int vt = 0; vt < 8; ++vt) { const bf16x8 av = (bf16x8){x0[vt][0], x0[vt][1], x0[vt][2], x0[vt][3], x1[vt][0], x1[vt][1], x1[vt][2], x1[vt][3]};
                    o[bq][vt] = __builtin_amdgcn_mfma_f32_16x16x32_bf16(av, pb, o[bq][vt], 0, 0, 0); }
            }
        }
        }
        if (t + 2 <= thi) NA_WRITE2(cur ^ 1);
        __syncthreads();
    }
#undef NA_LOAD2
#undef NA_WRITE2
#pragma unroll
    for (int bq = 0; bq < 2; ++bq) { float lt = l[bq]; lt += __shfl_xor(lt, 16); lt += __shfl_xor(lt, 32); const float linv = 1.0f / lt;
#pragma unroll
        for (int vt = 0; vt < 8; ++vt) { const u64 gt = *(const GAS u64*)(sgp[bq] + 16 * vt);
            const unsigned lo = pg8::cvt_pk_bf16(o[bq][vt][0] * linv * bflo((unsigned)gt), o[bq][vt][1] * linv * bfhi((unsigned)gt));
            const unsigned hi = pg8::cvt_pk_bf16(o[bq][vt][2] * linv * bflo((unsigned)(gt >> 32)), o[bq][vt][3] * linv * bfhi((unsigned)(gt >> 32)));
            *(GAS u64*)(ogp[bq] + 16 * vt) = (u64)lo | ((u64)hi << 32); } }
}
__device__ __forceinline__ float xmax16(float x) { auto r = __builtin_amdgcn_permlane16_swap(__float_as_uint(x), __float_as_uint(x), false, false); return fmaxf(__uint_as_float(r[0]), __uint_as_float(r[1])); }
__device__ __forceinline__ float xmax32(float x) { auto r = __builtin_amdgcn_permlane32_swap(__float_as_uint(x), __float_as_uint(x), false, false); return fmaxf(__uint_as_float(r[0]), __uint_as_float(r[1])); }
__device__ __forceinline__ float xsum16(float x) { auto r = __builtin_amdgcn_permlane16_swap(__float_as_uint(x), __float_as_uint(x), false, false); return __uint_as_float(r[0]) + __uint_as_float(r[1]); }
__device__ __forceinline__ float xsum32(float x) { auto r = __builtin_amdgcn_permlane32_swap(__float_as_uint(x), __float_as_uint(x), false, false); return __uint_as_float(r[0]) + __uint_as_float(r[1]); }
constexpr int NA3_SLOT = 32768;
__device__ __forceinline__ void na_item3(const Frame& F, const bf16* PROJ, const bf16* QH, bf16* OG, const float* rpb, int bi, int sl, int head, int rb) {
    constexpr float LOG2E = 1.4426950408889634f;
    const int W = F.wave, lane = F.lane, tid = F.tid, ql = lane & 15, g = lane >> 4;
    LAS unsigned char* L = F.lds + RING_OFF;
    __syncthreads();
    { LAS float* Bl = (LAS float*)(L + NA2_BIAS); const int dr = tid >> 5, dc = tid & 31;
      if (dr < 15) Bl[dr * 32 + dc] = dc < 31 ? rpb[((size_t)(bi * NHEAD + head) * 15 + dr) * 31 + dc] * LOG2E : 0.f; }
    const int r0 = 4 * rb, rq = r0 + (W >> 1), hq = W & 1;
    const int tlo = min(max(r0 - 4, 0), 56), thi = min(max(r0 + 3 - 4, 0), 56) + 7, alo = min(max(rq - 4, 0), 56), ahi = alo + 7;
    bf16x8 qf[2][4]; unsigned vmask[2]; int bidx[2][2], koff[2][2][4], vbase[2][2];
    const bf16* ogp[2]; const bf16* sgp[2];
#pragma unroll
    for (int bq = 0; bq < 2; ++bq) { const int b = 2 * hq + bq, kst = (b == 0) ? 0 : (b == 1) ? 8 : (b == 2) ? 24 : 32, qc = 16 * b + ql, cs = min(max(qc - 8, 0), 48);
        const size_t tok = (size_t)sl * SEQ + rq * 64 + qc;
#pragma unroll
        for (int s = 0; s < 4; ++s) qf[bq][s] = *(const GAS bf16x8*)(QH + ((size_t)head * GT + tok) * HD + 32 * s + 8 * g);
        ogp[bq] = OG + tok * MIXW + head * HD + 4 * g; sgp[bq] = PROJ + tok * P_B + GATE_B + head * HD + 4 * g;
        unsigned vm = 0;
#pragma unroll
        for (int blk = 0; blk < 2; ++blk) { const int kc0 = kst + 16 * blk + 4 * g;
#pragma unroll
            for (int r = 0; r < 4; ++r) vm |= ((kc0 + r >= cs && kc0 + r < cs + 16) ? 1u : 0u) << (4 * blk + r);
            bidx[bq][blk] = NA2_BIAS + 4 * (kc0 - qc + 15);
            const int krow = kst + 16 * blk + ql;
#pragma unroll
            for (int s = 0; s < 4; ++s) koff[bq][blk][s] = krow * 256 + (((4 * s + g) * 16) ^ ((krow & 7) << 4));
            const int kt = (kst >> 3) + 2 * blk + (g >> 1);
            vbase[bq][blk] = NA2_V + kt * 2048 + ((4 * g + (ql >> 2)) & 7) * 32 + 8 * (ql & 3); }
        vmask[bq] = vm; }
    f32x4a o[2][8];
#pragma unroll
    for (int bq = 0; bq < 2; ++bq)
#pragma unroll
        for (int vt = 0; vt < 8; ++vt) o[bq][vt] = (f32x4a){0.f, 0.f, 0.f, 0.f};
    float m[2] = {-1e30f, -1e30f}, l[2] = {0.f, 0.f};
    int dko[2], dvo[2];
#pragma unroll
    for (int i = 0; i < 2; ++i) { const int pc = 2 * W + i, row = 4 * pc + g, lc = ql ^ (row & 7); dko[i] = row * HD + lc * 8;
        const int kt = row >> 3, vt = row & 7, key = 8 * kt + (ql >> 1), col = 16 * vt + 8 * (ql & 1); dvo[i] = key * HD + col; }
    const bf16* kvb = QH + ((size_t)(NHEAD + head) * GT + (size_t)sl * SEQ) * HD;
    const int nt = thi - tlo + 1;
#define NA3_DMA(k_) do { const bf16* p_ = kvb + (size_t)(tlo + (k_)) * 64 * HD; constexpr size_t VO_ = (size_t)NHEAD * GT * HD; LAS unsigned char* d_ = L + ((k_) & 3) * NA3_SLOT + W * 2048; \
        __builtin_amdgcn_global_load_lds((const unsigned*)(p_ + dko[0]), (LAS unsigned*)(d_), 16, 0, 0); \
        __builtin_amdgcn_global_load_lds((const unsigned*)(p_ + dko[1]), (LAS unsigned*)(d_ + 1024), 16, 0, 0); \
        __builtin_amdgcn_global_load_lds((const unsigned*)(p_ + VO_ + dvo[0]), (LAS unsigned*)(d_ + NA2_V), 16, 0, 0); \
        __builtin_amdgcn_global_load_lds((const unsigned*)(p_ + VO_ + dvo[1]), (LAS unsigned*)(d_ + NA2_V + 1024), 16, 0, 0); } while (0)
    NA3_DMA(0); NA3_DMA(1);
#pragma unroll
    for (int bq = 0; bq < 2; ++bq)
#pragma unroll
        for (int s = 0; s < 4; ++s) asm volatile("" :: "v"(qf[bq][s]));
    for (int k = 0; k < nt; ++k) {
        if (k + 2 < nt) { NA3_DMA(k + 2); asm volatile("s_waitcnt vmcnt(8)" ::: "memory"); }
        else if (k + 1 < nt) asm volatile("s_waitcnt vmcnt(4)" ::: "memory");
        else asm volatile("s_waitcnt vmcnt(0)" ::: "memory");
        __builtin_amdgcn_s_barrier();
        asm volatile("" ::: "memory");
        const int tt = tlo + k;
        if (tt >= alo && tt <= ahi) {
            const LAS unsigned char* Lb = L + (k & 3) * NA3_SLOT; const int lb = (int)(size_t)Lb; const int dro = (tt - rq + 7) * 128;
            float bv[2][2][4]; bf16x8 kf[2][2][4];
#pragma unroll
            for (int bq = 0; bq < 2; ++bq)
#pragma unroll
                for (int blk = 0; blk < 2; ++blk) { const volatile LAS float* bp = (const volatile LAS float*)(L + bidx[bq][blk] + dro);
#pragma unroll
                    for (int r = 0; r < 4; ++r) bv[bq][blk][r] = bp[r]; }
#pragma unroll
            for (int bq = 0; bq < 2; ++bq)
#pragma unroll
                for (int blk = 0; blk < 2; ++blk)
#pragma unroll
                    for (int s = 0; s < 4; ++s) kf[bq][blk][s] = *(const LAS bf16x8*)(Lb + koff[bq][blk][s]);
            __builtin_amdgcn_sched_barrier(0);
            f32x4a p[2][2];
#pragma unroll
            for (int bq = 0; bq < 2; ++bq)
#pragma unroll
                for (int blk = 0; blk < 2; ++blk)
#pragma unroll
                    for (int r = 0; r < 4; ++r) p[bq][blk][r] = ((vmask[bq] >> (4 * blk + r)) & 1u) ? bv[bq][blk][r] : -1e30f;
#pragma unroll
            for (int s = 0; s < 4; ++s)
#pragma unroll
                for (int bq = 0; bq < 2; ++bq)
#pragma unroll
                    for (int blk = 0; blk < 2; ++blk) p[bq][blk] = __builtin_amdgcn_mfma_f32_16x16x32_bf16(kf[bq][blk][s], qf[bq][s], p[bq][blk], 0, 0, 0);
            float pm[2], al[2]; bf16x8 pb[2];
#pragma unroll
            for (int bq = 0; bq < 2; ++bq) pm[bq] = fmaxf(fmaxf(fmaxf(p[bq][0][0], p[bq][0][1]), fmaxf(p[bq][0][2], p[bq][0][3])), fmaxf(fmaxf(p[bq][1][0], p[bq][1][1]), fmaxf(p[bq][1][2], p[bq][1][3])));
#pragma unroll
            for (int bq = 0; bq < 2; ++bq) pm[bq] = xmax16(pm[bq]);
#pragma unroll
            for (int bq = 0; bq < 2; ++bq) pm[bq] = xmax32(pm[bq]);
#pragma unroll
            for (int bq = 0; bq < 2; ++bq) {
                const float mn = fmaxf(m[bq], pm[bq]); al[bq] = ex2(m[bq] - mn); m[bq] = mn;
                float ps = 0.f;
#pragma unroll
                for (int blk = 0; blk < 2; ++blk)
#pragma unroll
                    for (int r = 0; r < 4; ++r) { p[bq][blk][r] = ex2(p[bq][blk][r] - mn); ps += p[bq][blk][r]; }
                l[bq] = l[bq] * al[bq] + ps;
                pb[bq] = mk8(pg8::cvt_pk_bf16(p[bq][0][0], p[bq][0][1]), pg8::cvt_pk_bf16(p[bq][0][2], p[bq][0][3]), pg8::cvt_pk_bf16(p[bq][1][0], p[bq][1][1]), pg8::cvt_pk_bf16(p[bq][1][2], p[bq][1][3])); }
            if (__any(al[0] < 1.0f || al[1] < 1.0f)) {
#pragma unroll
                for (int bq = 0; bq < 2; ++bq)
#pragma unroll
                    for (int vt = 0; vt < 8; ++vt) o[bq][vt] *= al[bq]; }
            { const int va = lb + vbase[0][0], vb2 = lb + vbase[0][1], vc = lb + vbase[1][0], vd = lb + vbase[1][1];
                s16x4 x0[8], x1[8], y0[8], y1[8];
                x0[0] = tr_read_o<0>(va); x1[0] = tr_read_o<0>(vb2); x0[1] = tr_read_o<256>(va); x1[1] = tr_read_o<256>(vb2); x0[2] = tr_read_o<512>(va); x1[2] = tr_read_o<512>(vb2); x0[3] = tr_read_o<768>(va); x1[3] = tr_read_o<768>(vb2);
                x0[4] = tr_read_o<1024>(va); x1[4] = tr_read_o<1024>(vb2); x0[5] = tr_read_o<1280>(va); x1[5] = tr_read_o<1280>(vb2); x0[6] = tr_read_o<1536>(va); x1[6] = tr_read_o<1536>(vb2); x0[7] = tr_read_o<1792>(va); x1[7] = tr_read_o<1792>(vb2);
                y0[0] = tr_read_o<0>(vc); y1[0] = tr_read_o<0>(vd); y0[1] = tr_read_o<256>(vc); y1[1] = tr_read_o<256>(vd); y0[2] = tr_read_o<512>(vc); y1[2] = tr_read_o<512>(vd); y0[3] = tr_read_o<768>(vc); y1[3] = tr_read_o<768>(vd);
                y0[4] = tr_read_o<1024>(vc); y1[4] = tr_read_o<1024>(vd); y0[5] = tr_read_o<1280>(vc); y1[5] = tr_read_o<1280>(vd); y0[6] = tr_read_o<1536>(vc); y1[6] = tr_read_o<1536>(vd); y0[7] = tr_read_o<1792>(vc); y1[7] = tr_read_o<1792>(vd);
                asm volatile("s_waitcnt lgkmcnt(15)" ::: "memory"); __builtin_amdgcn_sched_barrier(0);
#pragma unroll
                for (int vt = 0; vt < 8; ++vt) { const bf16x8 av = (bf16x8){x0[vt][0], x0[vt][1], x0[vt][2], x0[vt][3], x1[vt][0], x1[vt][1], x1[vt][2], x1[vt][3]};
                    o[0][vt] = __builtin_amdgcn_mfma_f32_16x16x32_bf16(av, pb[0], o[0][vt], 0, 0, 0); }
                __builtin_amdgcn_sched_barrier(0); asm volatile("s_waitcnt lgkmcnt(0)" ::: "memory"); __builtin_amdgcn_sched_barrier(0);
#pragma unroll
                for (int vt = 0; vt < 8; ++vt) { const bf16x8 av = (bf16x8){y0[vt][0], y0[vt][1], y0[vt][2], y0[vt][3], y1[vt][0], y1[vt][1], y1[vt][2], y1[vt][3]};
                    o[1][vt] = __builtin_amdgcn_mfma_f32_16x16x32_bf16(av, pb[1], o[1][vt], 0, 0, 0); }
            }
        }
    }
#undef NA3_DMA
#pragma unroll
    for (int bq = 0; bq < 2; ++bq) { float lt = l[bq]; lt += __shfl_xor(lt, 16); lt += __shfl_xor(lt, 32); const float linv = 1.0f / lt;
#pragma unroll
        for (int vt = 0; vt < 8; ++vt) { const u64 gt = *(const GAS u64*)(sgp[bq] + 16 * vt);
            const unsigned lo = pg8::cvt_pk_bf16(o[bq][vt][0] * linv * bflo((unsigned)gt), o[bq][vt][1] * linv * bfhi((unsigned)gt));
            const unsigned hi = pg8::cvt_pk_bf16(o[bq][vt][2] * linv * bflo((unsigned)(gt >> 32)), o[bq][vt][3] * linv * bfhi((unsigned)(gt >> 32)));
            *(GAS u64*)(ogp[bq] + 16 * vt) = (u64)lo | ((u64)hi << 32); } }
}
constexpr int MM_BUF = 65536, MM_V = 32768;
__device__ __forceinline__ void mem_item2(const Frame& F, const bf16* PROJ, bf16* OG, const bf16* KV, int layer, int g, int tt, int mh) {
    constexpr float LOG2E = 1.4426950408889634f;
    const int W = F.wave, lane = F.lane, tid = F.tid, ql = lane & 15, gq = lane >> 4;
    LAS unsigned char* L = F.lds + RING_OFF;
    const int P = (layer & 1) ? P_B : P_A, QM = (layer & 1) ? QM_B : QM_A, GATE = (layer & 1) ? GATE_B : GATE_A;
    const int tau = tt * 128 + 16 * W + ql, seq = g * 2 + (tt >> 5);
    const bf16* kvb = KV + ((size_t)layer * 2560 + seq * NMEM) * 2048 + mh * MHD;
    __syncthreads();
    bf16x8 qf[8];
#pragma unroll
    for (int s = 0; s < 8; ++s) qf[s] = *(const GAS bf16x8*)(PROJ + (size_t)tau * P + QM + mh * MHD + 32 * s + 8 * gq);
    int koff[4]; int vb0[2], vb1[2];
#pragma unroll
    for (int blk = 0; blk < 4; ++blk) koff[blk] = (16 * blk + ql) * 512;
#pragma unroll
    for (int kk = 0; kk < 2; ++kk) { const int w8 = ((4 * gq + (ql >> 2)) & 7) * 32 + 8 * (ql & 3);
        vb0[kk] = MM_V + (4 * kk + (gq >> 1)) * 4096 + w8; vb1[kk] = MM_V + (4 * kk + 2 + (gq >> 1)) * 4096 + w8; }
    f32x4a o[16];
#pragma unroll
    for (int vt = 0; vt < 16; ++vt) o[vt] = (f32x4a){0.f, 0.f, 0.f, 0.f};
    float m = -1e30f, l = 0.f;
    bf16x8 ks[4], vs[4];
    int srow[4], sch[4];
#pragma unroll
    for (int i = 0; i < 4; ++i) { const int p = tid + 512 * i; srow[i] = p >> 5; sch[i] = p & 31; }
#define MM_LOAD(t_) do { _Pragma("unroll") for (int i = 0; i < 4; ++i) { const bf16* p_ = kvb + (size_t)(64 * (t_) + srow[i]) * 2048 + sch[i] * 8; \
        ks[i] = *(const GAS bf16x8*)(p_); vs[i] = *(const GAS bf16x8*)(p_ + MEMW); } } while (0)
#define MM_WRITE(B_) do { LAS unsigned char* d_ = L + (B_) * MM_BUF; _Pragma("unroll") for (int i = 0; i < 4; ++i) { \
        *(LAS bf16x8*)(d_ + srow[i] * 512 + ((sch[i] * 16) ^ ((srow[i] & 15) << 4))) = ks[i]; \
        *(LAS bf16x8*)(d_ + MM_V + ((srow[i] >> 3) * 16 + (sch[i] >> 1)) * 256 + (srow[i] & 7) * 32 + (sch[i] & 1) * 16) = vs[i]; } } while (0)
    MM_LOAD(0); MM_WRITE(0);
    __syncthreads();
    for (int t = 0; t < 4; ++t) {
        const int cur = t & 1;
        if (t < 3) MM_LOAD(t + 1);
        const LAS unsigned char* Lb = L + cur * MM_BUF; const int lb = (int)(size_t)Lb;
        f32x4a p[4];
#pragma unroll
        for (int blk = 0; blk < 4; ++blk) { p[blk] = (f32x4a){0.f, 0.f, 0.f, 0.f};
#pragma unroll
            for (int s = 0; s < 8; ++s) { const bf16x8 a = *(const LAS bf16x8*)(Lb + koff[blk] + (((4 * s + gq) * 16) ^ (ql << 4)));
                p[blk] = __builtin_amdgcn_mfma_f32_16x16x32_bf16(a, qf[s], p[blk], 0, 0, 0); } }
        float pm = -1e30f;
#pragma unroll
        for (int blk = 0; blk < 4; ++blk)
#pragma unroll
            for (int r = 0; r < 4; ++r) { p[blk][r] *= LOG2E; pm = fmaxf(pm, p[blk][r]); }
        pm = fmaxf(pm, __shfl_xor(pm, 16)); pm = fmaxf(pm, __shfl_xor(pm, 32));
        const float mn = fmaxf(m, pm), alpha = ex2(m - mn); m = mn;
        float ps = 0.f;
#pragma unroll
        for (int blk = 0; blk < 4; ++blk)
#pragma unroll
            for (int r = 0; r < 4; ++r) { p[blk][r] = ex2(p[blk][r] - mn); ps += p[blk][r]; }
        l = l * alpha + ps;
        if (__any(alpha < 1.0f)) {
#pragma unroll
            for (int vt = 0; vt < 16; ++vt) o[vt] *= alpha; }
#pragma unroll
        for (int kk = 0; kk < 2; ++kk) {
            const bf16x8 pb = mk8(pg8::cvt_pk_bf16(p[2 * kk][0], p[2 * kk][1]), pg8::cvt_pk_bf16(p[2 * kk][2], p[2 * kk][3]), pg8::cvt_pk_bf16(p[2 * kk + 1][0], p[2 * kk + 1][1]), pg8::cvt_pk_bf16(p[2 * kk + 1][2], p[2 * kk + 1][3]));
            const int va = lb + vb0[kk], vb2 = lb + vb1[kk];
#define MM_PV4(BASE_) do { s16x4 x0[4], x1[4]; \
                x0[0] = tr_read_o<(BASE_)>(va); x1[0] = tr_read_o<(BASE_)>(vb2); x0[1] = tr_read_o<(BASE_) + 256>(va); x1[1] = tr_read_o<(BASE_) + 256>(vb2); \
                x0[2] = tr_read_o<(BASE_) + 512>(va); x1[2] = tr_read_o<(BASE_) + 512>(vb2); x0[3] = tr_read_o<(BASE_) + 768>(va); x1[3] = tr_read_o<(BASE_) + 768>(vb2); \
                asm volatile("s_waitcnt lgkmcnt(0)" ::: "memory"); __builtin_amdgcn_sched_barrier(0); \
                _Pragma("unroll") for (int v4 = 0; v4 < 4; ++v4) { const bf16x8 av = (bf16x8){x0[v4][0], x0[v4][1], x0[v4][2], x0[v4][3], x1[v4][0], x1[v4][1], x1[v4][2], x1[v4][3]}; \
                    o[(BASE_) / 256 + v4] = __builtin_amdgcn_mfma_f32_16x16x32_bf16(av, pb, o[(BASE_) / 256 + v4], 0, 0, 0); } } while (0)
            MM_PV4(0); MM_PV4(1024); MM_PV4(2048); MM_PV4(3072);
#undef MM_PV4
        }
        if (t < 3) MM_WRITE(cur ^ 1);
        __syncthreads();
    }
#undef MM_LOAD
#undef MM_WRITE
    float lt = l; lt += __shfl_xor(lt, 16); lt += __shfl_xor(lt, 32); const float linv = 1.0f / lt;
    const bf16* sgp = PROJ + (size_t)tau * P + GATE + TOKW + mh * MHD + 4 * gq; bf16* ogp = OG + (size_t)tau * MIXW + TOKW + mh * MHD + 4 * gq;
#pragma unroll
    for (int vt = 0; vt < 16; ++vt) { const u64 gt = *(const GAS u64*)(sgp + 16 * vt);
        const unsigned lo = pg8::cvt_pk_bf16(o[vt][0] * linv * bflo((unsigned)gt), o[vt][1] * linv * bfhi((unsigned)gt));
        const unsigned hi = pg8::cvt_pk_bf16(o[vt][2] * linv * bflo((unsigned)(gt >> 32)), o[vt][3] * linv * bfhi((unsigned)(gt >> 32)));
        *(GAS u64*)(ogp + 16 * vt) = (u64)lo | ((u64)hi << 32); }
}
__device__ __forceinline__ void mem_item(const Frame& F, const bf16* PROJ, bf16* OG, const bf16* KV, int layer, int g, int tt, int mh, int vh) {
    const int W = F.wave, lane = F.lane, n = lane & 31, h = lane >> 5;
    const int P = (layer & 1) ? P_B : P_A, QM = (layer & 1) ? QM_B : QM_A, GATE = (layer & 1) ? GATE_B : GATE_A;
    const int tau = tt * 256 + 32 * W + n, seq = g * 2 + (tt >> 4);
    const bf16* kv = KV + ((size_t)layer * 2560 + seq * NMEM) * 2048;
    attn_item<16, false>(F, PROJ + (size_t)tau * P + QM + mh * MHD + 8 * h, kv, 2048, mh * MHD, MEMW + mh * MHD + vh * 128, 0, 3, 0, 3, 0, 0, 0,
                         OG + (size_t)tau * MIXW + TOKW + mh * MHD + vh * 128, PROJ + (size_t)tau * P + GATE + TOKW + mh * MHD + vh * 128);
}
#define FRESH_FRAME(Fx) Frame Fx = F0; Fx.lane = lane_id_fresh(); Fx.tid = Fx.wave * 64 + Fx.lane
__device__ __forceinline__ void p_mix_naive(const Frame& F0, int layer, int g, int item) {
    if (!(layer & 1)) {
        if (blockIdx.x < 96) { FRESH_FRAME(F); scan_opt(F, FWS(bf16, WS_PROJ), FWS(bf16, WS_OPART), (int)blockIdx.x); }
        else { for (int it = (int)blockIdx.x - 96; it < 256; it += F0.G - 96) {
                   const int pr = it & 7, tl = it >> 3; FRESH_FRAME(F); mem_item2(F, FWS(bf16, WS_PROJ), OGBUF(item), FWS(bf16, WS_KV), layer, g, (pr >> 2) * 32 + tl, pr & 3); } }
    } else {
        for (int k = 0; (int)blockIdx.x + F0.G * k < 768; ++k) {
            const int c = (int)blockIdx.x, it = c + F0.G * k; int pair, rbk;
            if (F0.G == 256) { pair = (c & 7) * 6 + 2 * k + ((c >> 3) >> 4); rbk = (c >> 3) & 15; } else { pair = it >> 4; rbk = it & 15; }
            FRESH_FRAME(F); na_item3(F, FWS(bf16, WS_PROJ), FWS(bf16, WS_OPART), OGBUF(item), FIN(12), layer >> 1, pair / NHEAD, pair % NHEAD, rbk); }
        for (int it = (int)blockIdx.x; it < 256; it += F0.G) { const int pr = it & 7, tl = it >> 3; FRESH_FRAME(F); mem_item2(F, FWS(bf16, WS_PROJ), OGBUF(item), FWS(bf16, WS_KV), layer, g, (pr >> 2) * 32 + tl, pr & 3); }
    }
}

__global__ void __launch_bounds__(NWAVES * 64, 2) fwd(Args args) {
    extern __shared__ __attribute__((aligned(16))) unsigned char lds[];
    Frame F;
    F.lds = (LAS unsigned char*)lds;
    F.MISC = (volatile LAS unsigned*)(F.lds + MISC_OFF);
    F.tid = threadIdx.x; F.lane = F.tid & 63; F.wave = __builtin_amdgcn_readfirstlane(F.tid >> 6); F.G = gridDim.x;
    for (int u = F.tid; u < (LDS_BYTES - LDSCTL_OFF) / 4; u += NWAVES * 64) ((LAS unsigned*)(F.lds + LDSCTL_OFF))[u] = 0u;
    __syncthreads();
    XcdBarrier bar = xcd_barrier_post(FWS(unsigned, WS_CTL) + CW_BAR, F.MISC + 8);
    const int s_lo = args.s_lo, s_hi = args.s_hi;
    int step = 0;
#define IN_STEP() (step >= s_lo && step < s_hi)
#ifndef PROBE_MASK
#define PROBE_MASK 0
#endif
#ifndef PROBE_MULT
#define PROBE_MULT 4
#endif
    unsigned long long pr_acc = 0, pr_last = PROBE_MASK ? rt() : 0ull;
#define SEAM_C(cls) do { if (step >= s_lo && step + 1 < s_hi) xcd_barrier(bar); ++step; \
        if (PROBE_MASK) { const unsigned long long now_ = rt(); if ((PROBE_MASK >> (cls)) & 1) pr_acc += now_ - pr_last; pr_last = now_; } } while (0)
#define SEAM() SEAM_C(0)

    if (IN_STEP()) { p_prologue(F); p_norm(F, 0, 0, 0); }
    SEAM();
    if (IN_STEP()) {
        pg8::Gemm gm{FWS(bf16, WS_MEMH), FWS(bf16, WS_WKV), NLAYER * 2560, 2048, DM}; pg8::KvOrder S{F.G, (int)blockIdx.x}; pg8::EpiKV E{FWS(bf16, WS_KV), 2048, 7};
        pg8::gemm_phase<pg8::EpiKV, pg8::KvOrder, true, true>(F.lds + RING_OFF, gm, S, E, F.wave);
    }
#ifndef DEFER_G2
#define DEFER_G2 1
#endif
#ifndef DEFER_W
#define DEFER_W 64
#endif
#define ITEM_IS_A(it) ((((it) / NGRP) & 1) == 0)
#define GEMM2_CALL(it_) do { const int l2_ = (it_) / NGRP, g2_ = (it_) % NGRP; \
        float* out_ = FOUT(); const float* base_ = l2_ > 0 ? out_ + (size_t)g2_ * GT * DM : (g2_ == 0 ? FIN(0) : FIN(1) + (size_t)(g2_ - 1) * GT * DM); \
        pg8::Gemm gm_{OGBUF(it_), FWS(bf16, WS_WOUT) + (size_t)l2_ * DM * MIXW, GT, DM, MIXW}; pg8::StaticOrder S_; S_.init(GT, DM, F.G, (int)blockIdx.x); \
        pg8::EpiResid E_{base_, out_ + (size_t)g2_ * GT * DM, DM}; \
        pg8::gemm_phase<pg8::EpiResid, pg8::StaticOrder, true, true>(F.lds + RING_OFF, gm_, S_, E_, F.wave); } while (0)
    for (int layer_ = 0; layer_ < NLAYER; ++layer_) {
        for (int g_ = 0; g_ < NGRP; ++g_) {
            if (IN_STEP()) {
                const int layer = opqs(layer_); const int isB = layer & 1, P = isB ? P_B : P_A; const int item = layer * NGRP + opqs(g_);
                const bf16* Bt = isB ? FWS(bf16, WS_WINB) + (size_t)(layer >> 1) * P_B * DM : FWS(bf16, WS_WINA) + (size_t)(layer >> 1) * P_A * DM;
                pg8::Gemm gm{FWS(bf16, WS_H), Bt, GT, P, DM}; pg8::ShiftOrder S; const bool dfr = DEFER_G2 && !isB && item > 0 && F.G == 256; S.init(GT, P, F.G, (int)blockIdx.x, 96, dfr ? DEFER_W : 0);
                pg8::EpiProj E{FWS(bf16, WS_PROJ), P, FWS(float, WS_LBVEC) + (layer >> 1) * 6144, isB, FWS(bf16, WS_OPART), isB ? 36 : 0, 0, GT};
                pg8::gemm_phase<pg8::EpiProj, pg8::ShiftOrder, true, true>(F.lds + RING_OFF, gm, S, E, F.wave);
            }
            SEAM_C(1 + (layer_ & 1));
            if (IN_STEP()) {
                const int layer = opqs(layer_), g = opqs(g_); const int item = layer * NGRP + g;
                if (DEFER_G2 && !(layer & 1) && item > 0 && F.G == 256 && blockIdx.x >= 96 && blockIdx.x < 96 + DEFER_W) GEMM2_CALL(item - 1);
                p_mix_naive(F, layer, g, item);
                const int wg0 = (layer & 1) ? 0 : 96;
                if (g + 1 < NGRP) p_norm(F, layer, g + 1, wg0); else if (layer + 1 < NLAYER) p_norm(F, layer + 1, 0, wg0);
            }
            SEAM_C(3 + (layer_ & 1));
            if (!(layer_ & 1)) {
                if (IN_STEP()) combine_naive(F, opqs(layer_) >> 1, opqs(layer_) * NGRP + opqs(g_));
                SEAM_C(5); }
            if (IN_STEP()) {
                const int item = opqs(layer_) * NGRP + opqs(g_);
                const bool split = DEFER_G2 && (item + 1 < NLAYER * NGRP) && ITEM_IS_A(item + 1) && F.G == 256;
                if (!split || blockIdx.x < 96 || blockIdx.x >= 96 + DEFER_W) GEMM2_CALL(item);
            }
        }
    }
    SEAM_C(6);
    if (IN_STEP()) p_final(F);
    if (PROBE_MASK) { const unsigned long long t0_ = rt(); while (rt() - t0_ < (unsigned long long)PROBE_MULT * pr_acc) __builtin_amdgcn_s_sleep(8); }
#undef IN_STEP
#undef SEAM
}

#ifndef MK_MULTI
#define MK_MULTI 0
#endif
extern "C" void kernel_launch(void* const* d_in, const int* in_sizes, int n_in, void* d_out, int out_size, void* d_ws, size_t ws_size, hipStream_t stream) {
    static int grid = 0;
    if (grid == 0) {
        if (n_in != 14 || out_size != NTOK * DM || ws_size < WS_END) { fprintf(stderr, "kernel_launch: unexpected shapes: n_in %d out %d ws %zu (need %zu)\n", n_in, out_size, ws_size, (size_t)WS_END); grid = -1; return; }
        int dev = 0, cus = 0, per_cu = 0;
        if (hipGetDevice(&dev) != hipSuccess || hipDeviceGetAttribute(&cus, hipDeviceAttributeMultiprocessorCount, dev) != hipSuccess) { grid = -1; return; }
        if (hipFuncSetAttribute((const void*)fwd, hipFuncAttributeMaxDynamicSharedMemorySize, LDS_BYTES) != hipSuccess) { fprintf(stderr, "kernel_launch: hipFuncSetAttribute failed\n"); grid = -1; return; }
        if (hipOccupancyMaxActiveBlocksPerMultiprocessor(&per_cu, (const void*)fwd, NWAVES * 64, LDS_BYTES) != hipSuccess || per_cu < 1) { fprintf(stderr, "kernel_launch: occupancy query says %d\n", per_cu); }
        (void)hipGetLastError();
        grid = cus;
    }
    if (grid < 0) return;
    if (hipMemsetAsync((char*)d_ws + WS_CTL, 0, CTL_ZERO_BYTES, stream) != hipSuccess) return;
    Args a{};
    for (int i = 0; i < 14; ++i) a.in[i] = (const float*)d_in[i];
    a.out = (float*)d_out; a.ws = (unsigned char*)d_ws;
    constexpr int NSTEPS = 3 + (NLAYER / 2) * NGRP * 5;
    if (MK_MULTI) {
        for (int s = 0; s < NSTEPS; ++s) { a.s_lo = s; a.s_hi = s + 1; hipLaunchKernelGGL(fwd, dim3(grid), dim3(NWAVES * 64), LDS_BYTES, stream, a); }
    } else {
        a.s_lo = 0; a.s_hi = 1 << 30; hipLaunchKernelGGL(fwd, dim3(grid), dim3(NWAVES * 64), LDS_BYTES, stream, a);
    }
    const hipError_t le = hipPeekAtLastError();
    if (le != hipSuccess) fprintf(stderr, "kernel_launch: launch failed: %s\n", hipGetErrorName(le));
}
```
